# Optimizing an MI355X kernel written in HIP

```python
import math
import jax, jax.numpy as jnp
from jax import lax
import numpy as np

D_MODEL = 1024
BATCH = 16
SEQ = 4096
DEPTH = 4

MLA_HEADS = 8
MLA_NOPE = 64
MLA_ROPE = 32
MLA_V = 64
MLA_QK = MLA_NOPE + MLA_ROPE
MLA_Q_RANK = 256
MLA_KV_RANK = 128
ROPE_THETA = 10000.0
Q_BLOCK = 128
MOBA_HEADS = 8
MOBA_HEAD_DIM = 64
MOBA_W = MOBA_HEADS * MOBA_HEAD_DIM
MOBA_BLOCK = 256
MOBA_TOPK = 3
MOBA_Q_CHUNK = 16
S5_GROUP = 16
S5_GROUPS = D_MODEL // S5_GROUP
S5_STATE = 64
S5_CHUNK = 128
DT_MIN = 1e-3
DT_MAX = 1e-1
D_FF = 4 * D_MODEL
EPS = 1e-6

N_EVEN = (DEPTH + 1) // 2
N_ODD = DEPTH // 2
IN_SIZES = [MLA_Q_RANK, MLA_KV_RANK, MLA_ROPE, MOBA_W, MOBA_W, MOBA_W]
IN_COLS = sum(IN_SIZES)
IN_SPLITS = [int(v) for v in np.cumsum(IN_SIZES)[:-1]]
MIX_WIDTH = MLA_HEADS * MLA_V + MOBA_W

kernel_name = "hybrid_mla_moba_s5_block"


def rms_norm(x, g):
    xf = x.astype(jnp.float32)
    y = xf * lax.rsqrt(jnp.mean(xf * xf, axis=-1, keepdims=True) + EPS)
    return (y * g.astype(jnp.float32)).astype(x.dtype)


def apply_rope(x, pos):
    half = x.shape[-1] // 2
    inv = ROPE_THETA ** (-jnp.arange(half, dtype=jnp.float32) / half)
    ang = pos.astype(jnp.float32)[:, None] * inv[None, :]
    cos = jnp.cos(ang).astype(x.dtype)
    sin = jnp.sin(ang).astype(x.dtype)
    x1, x2 = x[..., :half], x[..., half:]
    return jnp.concatenate([x1 * cos - x2 * sin, x1 * sin + x2 * cos], axis=-1)


def causal_attention_blocks(q, k, v):
    S = q.shape[2]
    outs = []
    for i in range(S // Q_BLOCK):
        lo, hi = i * Q_BLOCK, (i + 1) * Q_BLOCK
        s = jnp.einsum('bhqd,bhkd->bhqk', q[:, :, lo:hi], k[:, :, :hi]).astype(jnp.float32)
        mask = jnp.arange(hi)[None, :] <= jnp.arange(lo, hi)[:, None]
        p = jax.nn.softmax(jnp.where(mask, s, -jnp.inf), axis=-1).astype(v.dtype)
        outs.append(jnp.einsum('bhqk,bhkd->bhqd', p, v[:, :, :hi]))
    return jnp.concatenate(outs, axis=2)


def moba_attention(q, k, v):
    B, H, S, d = q.shape
    nb = -(-S // MOBA_BLOCK)
    pad = nb * MOBA_BLOCK - S
    kp = jnp.pad(k, ((0, 0), (0, 0), (0, pad), (0, 0)))
    vp = jnp.pad(v, ((0, 0), (0, 0), (0, pad), (0, 0)))
    k_blocks = kp.reshape(B, H, nb, MOBA_BLOCK, d)
    kv_blocks = jnp.concatenate([k_blocks, vp.reshape(B, H, nb, MOBA_BLOCK, d)], axis=-1)
    k_mean = jnp.mean(k_blocks.astype(jnp.float32), axis=3).astype(k.dtype)
    n_sel = min(MOBA_TOPK, nb - 1)
    b_idx = jnp.arange(B)[:, None, None, None]
    h_idx = jnp.arange(H)[None, :, None, None]
    blk_pos = jnp.arange(MOBA_BLOCK)

    def chunk(c):
        t0 = c * MOBA_Q_CHUNK
        qc = lax.dynamic_slice_in_dim(q, t0, MOBA_Q_CHUNK, axis=2)
        t = t0 + jnp.arange(MOBA_Q_CHUNK)
        cur = t0 // MOBA_BLOCK
        kv_own = lax.dynamic_index_in_dim(kv_blocks, cur, axis=2, keepdims=False)
        s_own = jnp.einsum('bhqd,bhld->bhql', qc, kv_own[..., :d]).astype(jnp.float32)
        s_own = jnp.where(cur * MOBA_BLOCK + blk_pos[None, :] <= t[:, None], s_own, -jnp.inf)
        if n_sel == 0:
            p = jax.nn.softmax(s_own, axis=-1).astype(v.dtype)
            return jnp.einsum('bhql,bhld->bhqd', p, kv_own[..., d:])
        gate = jnp.einsum('bhqd,bhnd->bhqn', qc, k_mean).astype(jnp.float32)
        gate = jnp.where(jnp.arange(nb) < cur, gate, -jnp.inf)
        _, sel = lax.top_k(gate, n_sel)
        sel_ok = jnp.arange(n_sel) < cur
        kv_sel = kv_blocks[b_idx, h_idx, sel]
        s_sel = jnp.einsum('bhqd,bhqnld->bhqnl', qc, kv_sel[..., :d]).astype(jnp.float32)
        s_sel = jnp.where(sel_ok[:, None], s_sel, -jnp.inf)
        s_sel = s_sel.reshape(B, H, MOBA_Q_CHUNK, n_sel * MOBA_BLOCK)
        p = jax.nn.softmax(jnp.concatenate([s_sel, s_own], axis=-1), axis=-1).astype(v.dtype)
        p_sel = p[..., :n_sel * MOBA_BLOCK].reshape(B, H, MOBA_Q_CHUNK, n_sel, MOBA_BLOCK)
        p_own = p[..., n_sel * MOBA_BLOCK:]
        return (jnp.einsum('bhqnl,bhqnld->bhqd', p_sel, kv_sel[..., d:])
                + jnp.einsum('bhql,bhld->bhqd', p_own, kv_own[..., d:]))

    outs = lax.map(chunk, jnp.arange(S // MOBA_Q_CHUNK))
    return outs.transpose(1, 2, 0, 3, 4).reshape(B, H, S, d)


def attn_mixer(h, w_in, g_cq, w_uq, g_ckv, w_ukv, g_qn_mla, g_kn_mla, g_qn_moba, g_kn_moba, w_o):
    B, S, _ = h.shape
    pos = jnp.arange(S)
    c_q, c_kv, k_r, q_b, k_b, v_b = jnp.split(h @ w_in, IN_SPLITS, axis=-1)
    q = (rms_norm(c_q, g_cq) @ w_uq).reshape(B, S, MLA_HEADS, MLA_QK).transpose(0, 2, 1, 3)
    kv = (rms_norm(c_kv, g_ckv) @ w_ukv).reshape(B, S, MLA_HEADS, MLA_NOPE + MLA_V).transpose(0, 2, 1, 3)
    k_nope, v = kv[..., :MLA_NOPE], kv[..., MLA_NOPE:]
    q = jnp.concatenate([q[..., :MLA_NOPE], apply_rope(q[..., MLA_NOPE:], pos)], axis=-1)
    k_rope = jnp.broadcast_to(apply_rope(k_r, pos)[:, None], (B, MLA_HEADS, S, MLA_ROPE))
    k = jnp.concatenate([k_nope, k_rope], axis=-1)
    q = rms_norm(q, g_qn_mla) * (MLA_QK ** -0.5)
    k = rms_norm(k, g_kn_mla)
    o_mla = causal_attention_blocks(q, k, v)
    def heads(t):
        return t.reshape(B, S, MOBA_HEADS, MOBA_HEAD_DIM).transpose(0, 2, 1, 3)
    qm = rms_norm(heads(q_b), g_qn_moba) * (MOBA_HEAD_DIM ** -0.5)
    km = rms_norm(heads(k_b), g_kn_moba)
    o_moba = moba_attention(qm, km, heads(v_b))
    o = jnp.concatenate([o_mla.transpose(0, 2, 1, 3).reshape(B, S, MLA_HEADS * MLA_V),
                         o_moba.transpose(0, 2, 1, 3).reshape(B, S, MOBA_W)], axis=-1)
    return o @ w_o


def s5_mixer(h, lam_re, lam_im, log_dt, b_re, b_im, c_re, c_im, d_skip, w_glu):
    B, S, D = h.shape
    f32 = jnp.float32
    u = h.astype(f32)
    lam = lax.complex(lam_re.astype(f32), lam_im.astype(f32))
    dt = jnp.exp(log_dt.astype(f32))[:, None]
    a_bar = jnp.exp(lam * dt)
    b_bar = ((a_bar - 1.0) / lam)[..., None] * lax.complex(b_re.astype(f32), b_im.astype(f32))
    cmat = lax.complex(c_re.astype(f32), c_im.astype(f32))
    nc = S // S5_CHUNK
    u_chunks = u.reshape(B, nc, S5_CHUNK, S5_GROUPS, S5_GROUP).transpose(1, 2, 0, 3, 4)
    steps = jnp.arange(1, S5_CHUNK + 1, dtype=f32)
    a_pow = jnp.exp(lam[None] * dt[None] * steps[:, None, None])
    a_el = jnp.broadcast_to(a_bar, (S5_CHUNK, 1, S5_GROUPS, S5_STATE))

    def combine(e1, e2):
        a1, b1 = e1
        a2, b2 = e2
        return a1 * a2, a2 * b1 + b2

    def step(state, uc):
        bu = jnp.einsum('gpi,lbgi->lbgp', b_bar, uc.astype(jnp.complex64))
        _, hs = lax.associative_scan(combine, (a_el, bu), axis=0)
        hs = hs + a_pow[:, None] * state[None]
        y = jnp.einsum('gop,lbgp->lbgo', cmat, hs).real
        return hs[-1], y

    state0 = jnp.zeros((B, S5_GROUPS, S5_STATE), jnp.complex64)
    _, ys = lax.scan(step, state0, u_chunks)
    y = ys.transpose(2, 0, 1, 3, 4).reshape(B, S, D) + d_skip.astype(f32) * u
    g = jax.nn.gelu(y).astype(h.dtype)
    val, gate = jnp.split(g @ w_glu, 2, axis=-1)
    return val * jax.nn.sigmoid(gate)


def sq_relu_mlp(h, w1, w2):
    return jnp.square(jax.nn.relu(h @ w1)) @ w2


def setup_inputs(seed: int = 0) -> dict:
    key = jax.random.key(seed)
    ks = iter(jax.random.split(key, 32))
    f32 = jnp.float32

    def nrm(shape, scale):
        return jax.random.normal(next(ks), shape, f32) * scale

    def gain(shape):
        return 1.0 + 0.02 * jax.random.normal(next(ks), shape, f32)

    n_idx = jnp.arange(S5_STATE, dtype=f32)
    return {
        "x": nrm((BATCH, SEQ, D_MODEL), 1.0),
        "mix_norm_g": gain((DEPTH, D_MODEL)),
        "ffn_norm_g": gain((DEPTH, D_MODEL)),
        "w_in": nrm((N_EVEN, D_MODEL, IN_COLS), D_MODEL ** -0.5),
        "g_cq": gain((N_EVEN, MLA_Q_RANK)),
        "w_uq": nrm((N_EVEN, MLA_Q_RANK, MLA_HEADS * MLA_QK), MLA_Q_RANK ** -0.5),
        "g_ckv": gain((N_EVEN, MLA_KV_RANK)),
        "w_ukv": nrm((N_EVEN, MLA_KV_RANK, MLA_HEADS * (MLA_NOPE + MLA_V)), MLA_KV_RANK ** -0.5),
        "g_qn_mla": gain((N_EVEN, MLA_QK)),
        "g_kn_mla": gain((N_EVEN, MLA_QK)),
        "g_qn_moba": gain((N_EVEN, MOBA_HEAD_DIM)),
        "g_kn_moba": gain((N_EVEN, MOBA_HEAD_DIM)),
        "w_o": nrm((N_EVEN, MIX_WIDTH, D_MODEL), MIX_WIDTH ** -0.5),
        "lam_re": -0.5 + nrm((N_ODD, S5_GROUPS, S5_STATE), 0.01),
        "lam_im": math.pi * n_idx + nrm((N_ODD, S5_GROUPS, S5_STATE), 0.01),
        "log_dt": jax.random.uniform(next(ks), (N_ODD, S5_GROUPS), f32, math.log(DT_MIN), math.log(DT_MAX)),
        "b_re": nrm((N_ODD, S5_GROUPS, S5_STATE, S5_GROUP), (2 * S5_GROUP) ** -0.5),
        "b_im": nrm((N_ODD, S5_GROUPS, S5_STATE, S5_GROUP), (2 * S5_GROUP) ** -0.5),
        "c_re": nrm((N_ODD, S5_GROUPS, S5_GROUP, S5_STATE), (2 * S5_STATE) ** -0.5),
        "c_im": nrm((N_ODD, S5_GROUPS, S5_GROUP, S5_STATE), (2 * S5_STATE) ** -0.5),
        "d_skip": nrm((N_ODD, D_MODEL), 1.0),
        "w_glu": nrm((N_ODD, D_MODEL, 2 * D_MODEL), D_MODEL ** -0.5),
        "w_ff1": nrm((DEPTH, D_MODEL, D_FF), D_MODEL ** -0.5),
        "w_ff2": nrm((DEPTH, D_FF, D_MODEL), D_FF ** -0.5),
    }


def reference(x, mix_norm_g, ffn_norm_g, w_in, g_cq, w_uq, g_ckv, w_ukv, g_qn_mla, g_kn_mla,
              g_qn_moba, g_kn_moba, w_o, lam_re, lam_im, log_dt, b_re, b_im, c_re, c_im,
              d_skip, w_glu, w_ff1, w_ff2):
    for layer in range(DEPTH):
        h = rms_norm(x, mix_norm_g[layer])
        i = layer // 2
        if layer % 2 == 0:
            x = x + attn_mixer(h, w_in[i], g_cq[i], w_uq[i], g_ckv[i], w_ukv[i], g_qn_mla[i],
                               g_kn_mla[i], g_qn_moba[i], g_kn_moba[i], w_o[i])
        else:
            x = x + s5_mixer(h, lam_re[i], lam_im[i], log_dt[i], b_re[i], b_im[i], c_re[i],
                             c_im[i], d_skip[i], w_glu[i]).astype(x.dtype)
        x = x + sq_relu_mlp(rms_norm(x, ffn_norm_g[layer]), w_ff1[layer], w_ff2[layer])
    return x
```

```cpp
#include <hip/hip_runtime.h>
#include <hip/hip_cooperative_groups.h>
#include <cstdio>
#include <cstdint>
namespace cg = cooperative_groups;

#define LAS __attribute__((address_space(3)))
typedef unsigned short bf16_t;
typedef short bf16x8 __attribute__((ext_vector_type(8)));
typedef float f32x4 __attribute__((ext_vector_type(4)));
typedef float f32x16 __attribute__((ext_vector_type(16)));
typedef unsigned u32x4 __attribute__((ext_vector_type(4)));
typedef unsigned u32x2 __attribute__((ext_vector_type(2)));
typedef float f32x2 __attribute__((ext_vector_type(2)));

constexpr int DM = 1024, NB = 16, SEQ = 4096, MTOK = NB * SEQ, DEPTH = 4, DFF = 4096;
constexpr int INC = 1952, INP = 2048;
constexpr int C_CQ = 0, C_CKV = 256, C_KR = 384, C_QB = 416, C_KB = 928, C_VB = 1440;
constexpr float EPS = 1e-6f, LOG2E = 1.4426950408889634f;
constexpr int S5L = 16, S5NC = SEQ / S5L;
constexpr int S5ROWS = 64 * NB * S5NC;
constexpr int S5K = 384;

constexpr size_t MiB = 1u << 20;
constexpr size_t WS_WIN = 1 * MiB, WS_WUQ = 9 * MiB, WS_WUKV = 10 * MiB, WS_WO = 11 * MiB, WS_WGLU = 15 * MiB, WS_W1 = 23 * MiB, WS_W2 = 55 * MiB;
constexpr size_t WS_S5A = 87 * MiB, WS_S5B = 103 * MiB, WS_A16 = 127 * MiB, WS_ROPE = 128 * MiB, WS_KMEAN = 129 * MiB, WS_FLAGS = 129 * MiB + 512 * 1024;
constexpr size_t WS_XN = 130 * MiB;
constexpr size_t WS_BIG = 258 * MiB;
constexpr size_t WS_HID = WS_BIG, WS_PROJ = WS_BIG, WS_QR = WS_BIG + 256 * MiB, WS_KVR = WS_BIG + 352 * MiB;
constexpr size_t WS_A2 = WS_BIG, WS_XS = WS_BIG + 192 * MiB, WS_GS = WS_BIG + 256 * MiB;
constexpr size_t WS_KM = 770 * MiB, WS_OB = 866 * MiB, WS_ROWSS = 994 * MiB, WS_RS = 1010 * MiB, WS_END = 1011 * MiB;

constexpr int LDS_BYTES = 147456;

__device__ __forceinline__ unsigned f2bf(float f) { unsigned u = __builtin_bit_cast(unsigned, f); return (u + 0x7fffu + ((u >> 16) & 1u)) >> 16; }
__device__ __forceinline__ unsigned pk2(float lo, float hi) { return f2bf(lo) | (f2bf(hi) << 16); }
__device__ __forceinline__ unsigned cvtpk(float lo, float hi) { typedef __bf16 b2 __attribute__((ext_vector_type(2))); f32x2 v = {lo, hi}; b2 b = __builtin_convertvector(v, b2); return __builtin_bit_cast(unsigned, b); }
__device__ __forceinline__ float bf_lo(unsigned w) { return __builtin_bit_cast(float, w << 16); }
__device__ __forceinline__ float bf_hi(unsigned w) { return __builtin_bit_cast(float, w & 0xffff0000u); }
__device__ __forceinline__ int lane_id() { return (int)__builtin_amdgcn_mbcnt_hi(~0u, __builtin_amdgcn_mbcnt_lo(~0u, 0u)); }
__device__ __forceinline__ int tid_of(int wv) { int t = wv * 64 + lane_id(); asm volatile("" : "+v"(t)); return t; }
__device__ __forceinline__ float bperm(int srclane, float v) { return __builtin_bit_cast(float, __builtin_amdgcn_ds_bpermute(srclane << 2, __builtin_bit_cast(int, v))); }
__device__ __forceinline__ float shx(float v, int o, int lane) { return bperm(lane ^ o, v); }
__device__ __forceinline__ float wave_sum(float v, int lane) {
#pragma unroll
    for (int o = 1; o < 64; o <<= 1) v += shx(v, o, lane);
    return v;
}
__device__ __forceinline__ void unpack8(const u32x4 w, float* f) { f[0] = bf_lo(w.x); f[1] = bf_hi(w.x); f[2] = bf_lo(w.y); f[3] = bf_hi(w.y); f[4] = bf_lo(w.z); f[5] = bf_hi(w.z); f[6] = bf_lo(w.w); f[7] = bf_hi(w.w); }
__device__ __forceinline__ u32x4 pack8(const float* f) { u32x4 w; w.x = cvtpk(f[0], f[1]); w.y = cvtpk(f[2], f[3]); w.z = cvtpk(f[4], f[5]); w.w = cvtpk(f[6], f[7]); return w; }

namespace pg8 {
constexpr int BM = 256, BK = 64, HALF = 128, HTB = HALF * BK * 2, STAGE_BYTES = 8 * HTB, NXCD = 8, WGM = 4;
__host__ __device__ __forceinline__ int lds_byte(int r, int c) { const int st = (r >> 4) * 2 + (c >> 5), rr = r & 15, cc = c & 31, ob = rr * 64 + cc * 2; return st * 1024 + (ob ^ (((ob >> 9) & 1) << 5)); }
__host__ __device__ __forceinline__ void stage_rc(int b, int& R, int& C) { const int st = b / 1024, sb = b % 1024, swz = sb ^ (((sb >> 9) & 1) << 5); R = (st >> 1) * 16 + swz / 64; C = (st & 1) * 32 + (swz % 64) / 2; }
__host__ __device__ __forceinline__ int perm32(int rho) { const int n = rho >> 4, i = rho & 15; return 8 * (i >> 2) + 4 * n + (i & 3); }
struct Unit { int pm, pn; };
struct Gemm { const bf16_t* A; const bf16_t* Bt; int M, N, K, lda, ldb, bgrp, amode; };
struct StaticOrder {
    int nM, nN, nwg, G, c;
    __device__ void init(int M, int N, int G_, int c_) { nM = M / BM; nN = N / BM; nwg = nM * nN; G = G_; c = c_; }
    __device__ bool next(int i, Unit& u) const {
        const long L = (long)i * G + c; if (L >= nwg) return false;
        int wgid = (int)L; { const int q = nwg / NXCD, r = nwg % NXCD, xcd = wgid % NXCD, off = wgid / NXCD; wgid = (xcd < r ? xcd * (q + 1) : r * (q + 1) + (xcd - r) * q) + off; }
        const int nig = WGM * nN, gid = wgid / nig, fm = gid * WGM, gsz = (nM - fm) < WGM ? (nM - fm) : WGM;
        u.pm = fm + ((wgid % nig) % gsz); u.pn = (wgid % nig) / gsz; return true;
    }
};
template <class Epi>
__device__ __forceinline__ void gemm_phase(LAS unsigned char* lds, const Gemm g, const StaticOrder& S, const Epi& E, const int wv) {
    const int tid = tid_of(wv);
    const int wid = __builtin_amdgcn_readfirstlane(tid >> 6), lane = tid & 63, wr = wid >> 2, wc = wid & 3, fr = lane & 15, fq = lane >> 4;
    const int nt = g.K / BK;
    unsigned voffA[2], voffB[2];
#pragma unroll
    for (int i = 0; i < 2; ++i) { int R, C; stage_rc(tid * 16 + i * 8192, R, C); const int Rb = (R & ~31) + perm32(R & 31);
        voffA[i] = g.amode ? (unsigned)((C >> 4) * (g.M * 16) + R * 16 + (C & 15)) * 2u : (unsigned)(R * g.lda + C) * 2u; voffB[i] = (unsigned)(Rb * g.ldb + C) * 2u; }
    const size_t kstep = (size_t)(BK * 2), kstepA = g.amode ? (size_t)4 * g.M * 16 * 2 : kstep;
    const size_t hsA = (size_t)HALF * g.lda * 2, hsB = (size_t)HALF * g.ldb * 2, tsA = 2 * hsA, tsB = 2 * hsB;
    const unsigned ldsw = (unsigned)wid * 1024u;
    const int aoff = lds_byte(wr * 64 + fr, fq * 8), boff = lds_byte(wc * 32 + fr, fq * 8);
#define PG8_SA(b, h) (((b) * 2 + (h)) * HTB)
#define PG8_SB(b, h) ((4 + (b) * 2 + (h)) * HTB)
#define PG8_STAGE(bufoff, gbase, voff) do { _Pragma("unroll") for (int _i = 0; _i < 2; ++_i) \
        __builtin_amdgcn_global_load_lds((const unsigned*)((const char*)(gbase) + (voff)[_i]), (LAS unsigned*)(lds + (bufoff) + ldsw + _i * 8192), 16, 0, 0); } while (0)
#define PG8_LDA(dst, b, h) do { _Pragma("unroll") for (int m = 0; m < 4; ++m) _Pragma("unroll") for (int k = 0; k < 2; ++k) dst[m][k] = *(const LAS bf16x8*)(lds + PG8_SA(b, h) + aoff + m * 2048 + k * 1024); } while (0)
#define PG8_LDB(dst, b, h) do { _Pragma("unroll") for (int n = 0; n < 2; ++n) _Pragma("unroll") for (int k = 0; k < 2; ++k) dst[n][k] = *(const LAS bf16x8*)(lds + PG8_SB(b, h) + boff + n * 2048 + k * 1024); } while (0)
#define PG8_MMA(ai, bj, At, Bt) do { __builtin_amdgcn_s_setprio(1); _Pragma("unroll") for (int m = 0; m < 4; ++m) _Pragma("unroll") for (int n = 0; n < 2; ++n) _Pragma("unroll") for (int k = 0; k < 2; ++k) \
        acc[ai][bj][m][n] = __builtin_amdgcn_mfma_f32_16x16x32_bf16(Bt[n][k], At[m][k], acc[ai][bj][m][n], 0, 0, 0); __builtin_amdgcn_s_setprio(0); } while (0)
#define PG8_WAIT_V(n) asm volatile("s_waitcnt vmcnt(" #n ")" ::: "memory")
#define PG8_WAIT_L(n) asm volatile("s_waitcnt lgkmcnt(" #n ")" ::: "memory")
#define PG8_BAR __builtin_amdgcn_s_barrier()
#define PG8_SCHED __builtin_amdgcn_sched_barrier(0)
#define PG8_BIDX(u) (g.bgrp >= 0 ? ((u).pm >> g.bgrp) : (u).pn)
    Unit cur, nxt; int ui = 0;
    if (!S.next(0, cur)) return;
    f32x4 acc[2][2][4][2];
#pragma unroll
    for (int a = 0; a < 2; ++a)
#pragma unroll
        for (int b = 0; b < 2; ++b)
#pragma unroll
            for (int m = 0; m < 4; ++m)
#pragma unroll
                for (int n = 0; n < 2; ++n) acc[a][b][m][n] = (f32x4){0.f, 0.f, 0.f, 0.f};
    bf16x8 At[4][2], B0[2][2], B1[2][2];
    const char* cA = (const char*)g.A + (size_t)cur.pm * tsA; const char* cB = (const char*)g.Bt + (size_t)PG8_BIDX(cur) * tsB;
    PG8_STAGE(PG8_SB(0, 0), cB, voffB); PG8_STAGE(PG8_SB(0, 1), cB + hsB, voffB); PG8_STAGE(PG8_SA(0, 0), cA, voffA); PG8_STAGE(PG8_SA(0, 1), cA + hsA, voffA);
    if (wr == 1) PG8_BAR;
    PG8_WAIT_V(2); PG8_BAR;
    PG8_STAGE(PG8_SB(1, 0), cB + kstep, voffB); PG8_STAGE(PG8_SA(1, 0), cA + kstepA, voffA); PG8_STAGE(PG8_SB(1, 1), cB + hsB + kstep, voffB);
    PG8_WAIT_V(6); PG8_BAR;
    for (;;) {
        const bool has_next = S.next(ui + 1, nxt);
        const char* nA = has_next ? (const char*)g.A + (size_t)nxt.pm * tsA : cA; const char* nB = has_next ? (const char*)g.Bt + (size_t)PG8_BIDX(nxt) * tsB : cB;
#pragma unroll 1
        for (int t = 0; t < nt; t += 2) {
            const bool last = (t == nt - 2);
            const char* a1 = cA + (size_t)(t + 1) * kstepA;
            const char* a2 = last ? nA : cA + (size_t)(t + 2) * kstepA; const char* b2 = last ? nB : cB + (size_t)(t + 2) * kstep;
            const char* a3 = a2 + kstepA; const char* b3 = b2 + kstep;
            asm volatile("" : "+s"(a1), "+s"(a2), "+s"(b2), "+s"(a3), "+s"(b3));
            PG8_LDB(B0, 0, 0); PG8_LDB(B1, 0, 1); PG8_SCHED; PG8_LDA(At, 0, 0); PG8_STAGE(PG8_SA(1, 1), a1 + hsA, voffA);
            PG8_WAIT_V(8); PG8_WAIT_L(0); PG8_BAR; PG8_MMA(0, 0, At, B0); PG8_MMA(0, 1, At, B1); PG8_BAR; PG8_SCHED;
            PG8_LDA(At, 0, 1); PG8_STAGE(PG8_SB(0, 0), b2, voffB); PG8_STAGE(PG8_SB(0, 1), b2 + hsB, voffB); PG8_STAGE(PG8_SA(0, 0), a2, voffA);
            PG8_WAIT_V(8); PG8_WAIT_L(0); PG8_BAR; PG8_MMA(1, 0, At, B0); PG8_MMA(1, 1, At, B1); PG8_BAR; PG8_SCHED;
            PG8_LDB(B0, 1, 0); PG8_LDB(B1, 1, 1); PG8_SCHED; PG8_LDA(At, 1, 0); PG8_STAGE(PG8_SA(0, 1), a2 + hsA, voffA);
            PG8_WAIT_V(8); PG8_WAIT_L(0); PG8_BAR; PG8_MMA(0, 0, At, B0); PG8_MMA(0, 1, At, B1); PG8_BAR; PG8_SCHED;
            PG8_LDA(At, 1, 1); PG8_STAGE(PG8_SB(1, 0), b3, voffB); PG8_STAGE(PG8_SB(1, 1), b3 + hsB, voffB); PG8_STAGE(PG8_SA(1, 0), a3, voffA);
            PG8_WAIT_V(8); PG8_WAIT_L(0); PG8_BAR; PG8_MMA(1, 0, At, B0); PG8_MMA(1, 1, At, B1); PG8_BAR; PG8_SCHED;
        }
        if (wr == 0) PG8_BAR;
        E(acc, cur, wr, wc, fr, fq);
        if (!has_next) break;
#pragma unroll
        for (int a = 0; a < 2; ++a)
#pragma unroll
            for (int b = 0; b < 2; ++b)
#pragma unroll
                for (int m = 0; m < 4; ++m)
#pragma unroll
                    for (int n = 0; n < 2; ++n) acc[a][b][m][n] = (f32x4){0.f, 0.f, 0.f, 0.f};
        cur = nxt; cA = nA; cB = nB; ++ui;
        if (wr == 1) PG8_BAR;
    }
    PG8_WAIT_V(0);
    PG8_BAR;
#undef PG8_SA
#undef PG8_SB
#undef PG8_STAGE
#undef PG8_LDA
#undef PG8_LDB
#undef PG8_MMA
#undef PG8_WAIT_V
#undef PG8_WAIT_L
#undef PG8_BAR
#undef PG8_SCHED
#undef PG8_BIDX
}
}
using pg8::Unit;
typedef const f32x4 (&AccRef)[2][2][4][2];

__device__ __forceinline__ float row_rs(const float* part, int r, int nslots) {
    const float* p = part + (size_t)r * 32; float s;
    if (nslots == 1) s = p[0];
    else { f32x4 a = ((const f32x4*)p)[0];
        for (int k = 1; k < nslots / 4; ++k) a += ((const f32x4*)p)[k];
        s = (a.x + a.y) + (a.z + a.w); }
    return rsqrtf(s * (1.f / DM) + EPS);
}
template <int ACT, int NBJ> struct EpiBf16 {
    bf16_t* O; int ldc; const float* rowss; int nslots;
    __device__ __forceinline__ void operator()(AccRef acc, const Unit& u, int wr, int wc, int fr, int fq) const {
        const int row0 = u.pm * 256 + wr * 64 + fr, col0 = u.pn * 256 + wc * 32 + 8 * fq;
#pragma unroll
        for (int ai = 0; ai < 2; ++ai)
#pragma unroll
            for (int m = 0; m < 4; ++m) { bf16_t* rowp = O + (size_t)(row0 + ai * 128 + m * 16) * ldc + col0;
                const float rsc = rowss ? rowss[row0 + ai * 128 + m * 16] : 1.f;
#pragma unroll
                for (int bj = 0; bj < NBJ; ++bj) { f32x4 v0 = acc[ai][bj][m][0] * rsc, v1 = acc[ai][bj][m][1] * rsc;
                    if (ACT == 1) {
#pragma unroll
                        for (int e = 0; e < 4; ++e) { float a = fmaxf(v0[e], 0.f), b = fmaxf(v1[e], 0.f); v0[e] = a * a; v1[e] = b * b; } }
                    u32x4 w; w.x = cvtpk(v0[0], v0[1]); w.y = cvtpk(v0[2], v0[3]); w.z = cvtpk(v1[0], v1[1]); w.w = cvtpk(v1[2], v1[3]);
                    if (ACT == 1) __builtin_nontemporal_store(w, (u32x4*)(rowp + bj * 128)); else *(u32x4*)(rowp + bj * 128) = w; } }
    }
};
struct EpiResid {
    bf16_t* xb; float* rowss; float* outf;
    __device__ __forceinline__ void operator()(AccRef acc, const Unit& u, int wr, int wc, int fr, int fq) const {
        const int row0 = u.pm * 256 + wr * 64 + fr, col0 = u.pn * 256 + wc * 32 + 8 * fq, lane = fq * 16 + fr;
        u32x4 xin[2][4][2];
#pragma unroll
        for (int ai = 0; ai < 2; ++ai)
#pragma unroll
            for (int m = 0; m < 4; ++m)
#pragma unroll
                for (int bj = 0; bj < 2; ++bj) xin[ai][m][bj] = *(const u32x4*)(xb + (size_t)(row0 + ai * 128 + m * 16) * DM + col0 + bj * 128);
#pragma unroll
        for (int ai = 0; ai < 2; ++ai)
#pragma unroll
            for (int m = 0; m < 4; ++m) { const size_t off = (size_t)(row0 + ai * 128 + m * 16) * DM + col0; float ss = 0.f;
#pragma unroll
                for (int bj = 0; bj < 2; ++bj) {
                    float b[8]; unpack8(xin[ai][m][bj], b);
                    const f32x4 a0 = acc[ai][bj][m][0], a1 = acc[ai][bj][m][1];
                    float o[8];
#pragma unroll
                    for (int e = 0; e < 4; ++e) { o[e] = b[e] + a0[e]; o[4 + e] = b[4 + e] + a1[e]; }
                    if (outf) { *(f32x4*)(outf + off + bj * 128) = (f32x4){o[0], o[1], o[2], o[3]}; *(f32x4*)(outf + off + bj * 128 + 4) = (f32x4){o[4], o[5], o[6], o[7]}; }
                    else { *(u32x4*)(xb + off + bj * 128) = pack8(o);
#pragma unroll
                        for (int e = 0; e < 8; ++e) ss += o[e] * o[e]; } }
                if (!outf) { ss += shx(ss, 16, lane); ss += shx(ss, 32, lane); if (fq == 0) rowss[(size_t)(row0 + ai * 128 + m * 16) * 32 + u.pn * 4 + wc] = ss; } }
    }
};
struct EpiGlu {
    bf16_t* xb; float* rowss;
    __device__ __forceinline__ void operator()(AccRef acc, const Unit& u, int wr, int wc, int fr, int fq) const {
        const int row0 = u.pm * 256 + wr * 64 + fr, col0 = u.pn * 128 + wc * 32 + 8 * fq, lane = fq * 16 + fr;
        u32x4 xin[2][4];
#pragma unroll
        for (int ai = 0; ai < 2; ++ai)
#pragma unroll
            for (int m = 0; m < 4; ++m) xin[ai][m] = *(const u32x4*)(xb + (size_t)(row0 + ai * 128 + m * 16) * DM + col0);
#pragma unroll
        for (int ai = 0; ai < 2; ++ai)
#pragma unroll
            for (int m = 0; m < 4; ++m) { const size_t off = (size_t)(row0 + ai * 128 + m * 16) * DM + col0; float ss = 0.f;
                float b[8], o[8]; unpack8(xin[ai][m], b);
#pragma unroll
                for (int n = 0; n < 2; ++n) { const f32x4 v = acc[ai][0][m][n], gt = acc[ai][1][m][n];
#pragma unroll
                    for (int e = 0; e < 4; ++e) { o[4 * n + e] = b[4 * n + e] + v[e] * __builtin_amdgcn_rcpf(1.f + __builtin_amdgcn_exp2f(-gt[e] * LOG2E)); ss += o[4 * n + e] * o[4 * n + e]; } }
                *(u32x4*)(xb + off) = pack8(o);
                ss += shx(ss, 16, lane); ss += shx(ss, 32, lane); if (fq == 0) rowss[(size_t)(row0 + ai * 128 + m * 16) * 32 + u.pn * 4 + wc] = ss; }
    }
};
struct EpiS5Y {
    bf16_t* G;
    __device__ __forceinline__ void operator()(AccRef acc, const Unit& u, int wr, int wc, int fr, int fq) const {
        const int row0 = u.pm * 256 + wr * 64 + fr;
#pragma unroll
        for (int ai = 0; ai < 2; ++ai)
#pragma unroll
            for (int m = 0; m < 4; ++m) { const int r = row0 + ai * 128 + m * 16; const int grp = r >> 12, rc = r & 4095, b = rc >> 8, c = rc & 255;
#pragma unroll
                for (int bj = 0; bj < 2; ++bj) { const int n0 = bj * 128 + wc * 32 + 8 * fq, l = n0 >> 4, o0 = n0 & 15;
                    float y[8];
#pragma unroll
                    for (int e = 0; e < 4; ++e) { y[e] = acc[ai][bj][m][0][e]; y[4 + e] = acc[ai][bj][m][1][e]; }
#pragma unroll
                    for (int e = 0; e < 8; ++e) { const float v = y[e], t = 0.7978845608f * (v + 0.044715f * v * v * v); y[e] = v * __builtin_amdgcn_rcpf(1.f + __builtin_amdgcn_exp2f(-2.f * LOG2E * t)); }
                    *(u32x4*)(G + ((size_t)grp * MTOK + (b * SEQ + c * S5L + l)) * 16 + o0) = pack8(y);     asm volatile("" ::: "memory"); } }
    }
};

__device__ __forceinline__ int crow(int r, int hi) { return (r & 3) + 8 * (r >> 2) + 4 * hi; }
typedef short v4i16_t __attribute__((ext_vector_type(4)));
__device__ __forceinline__ v4i16_t vtr(const LAS char* p) { return __builtin_amdgcn_ds_read_tr16_b64_v4i16((LAS v4i16_t*)p); }

__device__ __forceinline__ float swap32_other(float v, int hi) {
    const unsigned u = __builtin_bit_cast(unsigned, v);
    auto rr = __builtin_amdgcn_permlane32_swap(u, u, false, false);
    return __builtin_bit_cast(float, hi ? rr[0] : rr[1]);
}
template <int DK, bool MOBA>
__device__ __forceinline__ void attn_head(const bf16_t* __restrict__ Q, int ldq, const bf16_t* __restrict__ K, int ldk, const bf16_t* __restrict__ V, int ldv,
                                          bf16_t* __restrict__ O, int ldo, const bf16_t* __restrict__ kmean, LAS char* lds, unsigned qmask, const int wv, const bool fast) {
    constexpr int KS = DK * 2 + 16, VS = 192, KCH = DK / 8, NDS = DK / 16;
    constexpr int KBUF = 64 * KS, VBUF = 64 * VS;
    constexpr int VOFF = 2 * KBUF;
    const int tid = tid_of(wv);
    const int lane = tid & 63, wid = __builtin_amdgcn_readfirstlane(tid >> 6), r32 = lane & 31, hi = lane >> 5;
    const int kr0 = tid / KCH, kc0 = tid % KCH, kr1 = (tid + 512) / KCH, kc1 = (tid + 512) % KCH;
    const bool k2 = (DK == 96) && (tid + 512 < 64 * KCH);
    const int vr = tid >> 3, vc = tid & 7;
    const int i16 = lane & 15, cb = (lane >> 4) & 1;
    const int vlane = (4 * hi + (i16 >> 2)) * VS + (16 * cb + 4 * (i16 & 3)) * 2;
    const short one_b = (r32 == 0) ? (short)0x3F80 : (short)0;
    const bf16x8 onesf = (bf16x8){one_b, one_b, one_b, one_b, one_b, one_b, one_b, one_b};
#define AT_LOADK(t_) do { const size_t rb_ = (size_t)(t_) * 64; kg0 = *(const u32x4*)(K + (rb_ + kr0) * ldk + kc0 * 8); if (k2) kg1 = *(const u32x4*)(K + (rb_ + kr1) * ldk + kc1 * 8); } while (0)
#define AT_LOADV(t_) do { const size_t rb_ = (size_t)(t_) * 64; vg = *(const u32x4*)(V + (rb_ + vr) * ldv + vc * 8); } while (0)
#define AT_STK(slot_) do { LAS char* kb_ = lds + (slot_) * KBUF; *(LAS u32x4*)(kb_ + kr0 * KS + kc0 * 16) = kg0; if (k2) *(LAS u32x4*)(kb_ + kr1 * KS + kc1 * 16) = kg1; } while (0)
#define AT_STV(slot_) do { *(LAS u32x4*)(lds + VOFF + (slot_) * VBUF + vr * VS + vc * 16) = vg; } while (0)
#define AT_QK(P0_, P1_, slot_) do { const LAS char* kb_ = lds + (slot_) * KBUF; \
        _Pragma("unroll") for (int ds = 0; ds < NDS; ++ds) { \
            const bf16x8 ka_ = *(const LAS bf16x8*)(kb_ + r32 * KS + (ds * 16 + hi * 8) * 2); \
            const bf16x8 kc_ = *(const LAS bf16x8*)(kb_ + (32 + r32) * KS + (ds * 16 + hi * 8) * 2); \
            if (ds == 0) { P0_ = __builtin_amdgcn_mfma_f32_32x32x16_bf16(ka_, qf[0], MOBA ? cbias : zero16, 0, 0, 0); P1_ = __builtin_amdgcn_mfma_f32_32x32x16_bf16(kc_, qf[0], MOBA ? cbias : zero16, 0, 0, 0); } \
            else { P0_ = __builtin_amdgcn_mfma_f32_32x32x16_bf16(ka_, qf[ds], P0_, 0, 0, 0); P1_ = __builtin_amdgcn_mfma_f32_32x32x16_bf16(kc_, qf[ds], P1_, 0, 0, 0); } } } while (0)
#define AT_CBIAS(tt_) do { if (MOBA) { const float b_ = ((tt_) < 4 * qb && !((sel >> ((tt_) >> 2)) & 1u)) ? -INFINITY : 0.f; \
        _Pragma("unroll") for (int r = 0; r < 16; ++r) cbias[r] = b_; } } while (0)
    const f32x16 zero16 = (f32x16){0.f, 0.f, 0.f, 0.f, 0.f, 0.f, 0.f, 0.f, 0.f, 0.f, 0.f, 0.f, 0.f, 0.f, 0.f, 0.f};
    if (wid < 4) __builtin_amdgcn_s_setprio(2);
    for (int qb = 15; qb >= 0; --qb) {
        if (!((qmask >> qb) & 1u)) continue;
        const int qrow = qb * 256 + wid * 32 + r32;
        bf16x8 qf[NDS];
#pragma unroll
        for (int ds = 0; ds < NDS; ++ds) qf[ds] = *(const bf16x8*)(Q + (size_t)qrow * ldq + ds * 16 + hi * 8);
        u32x4 kg0, kg1 = (u32x4){0, 0, 0, 0}, vg, kh0, kh1 = (u32x4){0, 0, 0, 0};
        AT_LOADK(0); AT_LOADV(0);
        kh0 = *(const u32x4*)(K + (size_t)(64 + kr0) * ldk + kc0 * 8); if (k2) kh1 = *(const u32x4*)(K + (size_t)(64 + kr1) * ldk + kc1 * 8);
        unsigned sel = 0;
        if (MOBA) {
            if (qb > 0) {
                f32x16 ga = zero16;
#pragma unroll
                for (int ds = 0; ds < 4; ++ds) { const bf16x8 a = *(const bf16x8*)(kmean + (r32 & 15) * 64 + ds * 16 + hi * 8); ga = __builtin_amdgcn_mfma_f32_32x32x16_bf16(a, qf[ds], ga, 0, 0, 0); }
                float gv[16];
#pragma unroll
                for (int r = 0; r < 8; ++r) { const float mine = ga[r], other = swap32_other(mine, hi); const int blk = (r & 3) + 8 * (r >> 2);
                    gv[blk] = hi ? other : mine; gv[blk + 4] = hi ? mine : other; }
#pragma unroll
                for (int j = 0; j < 16; ++j) if (j >= qb) gv[j] = -INFINITY;
#pragma unroll
                for (int it = 0; it < 3; ++it) { float best = -INFINITY; int bi = 0;
#pragma unroll
                    for (int j = 0; j < 16; ++j) if (gv[j] > best) { best = gv[j]; bi = j; }
                    if (best > -INFINITY) { sel |= 1u << bi;
#pragma unroll
                        for (int j = 0; j < 16; ++j) if (j == bi) gv[j] = -INFINITY; } }
            }
        }
        float mref = 0.f; f32x16 o0 = zero16, o1 = zero16, o2 = zero16, cbias = zero16;
        const int nt = 4 * (qb + 1);
        AT_STK(0); AT_STV(0);
        { LAS char* kb_ = lds + KBUF; *(LAS u32x4*)(kb_ + kr0 * KS + kc0 * 16) = kh0; if (k2) *(LAS u32x4*)(kb_ + kr1 * KS + kc1 * 16) = kh1; }
        __syncthreads();
        f32x16 pa0, pa1, pb0, pb1;
        AT_CBIAS(0);
        AT_QK(pa0, pa1, 0);
#define AT_STEP(HASNEXT, FAST, C0, C1, N0, N1) do { \
            const LAS char* vb = lds + VOFF + (t & 1) * VBUF; \
            if (t + 2 < nt) AT_LOADK(t + 2); \
            if (t + 1 < nt) AT_LOADV(t + 1); \
            if (!(FAST)) { if (__builtin_expect(__ballot(mref != 0.f) != 0ull, 0)) { _Pragma("unroll") for (int r = 0; r < 16; ++r) { C0[r] -= mref; C1[r] -= mref; } } } \
            if (t >= 4 * qb) { const int qrel = 32 * wid + r32, tl = t - 4 * qb; \
                _Pragma("unroll") for (int r = 0; r < 16; ++r) { const int key = 64 * tl + crow(r, hi); if (key > qrel) C0[r] = -INFINITY; if (key + 32 > qrel) C1[r] = -INFINITY; } } \
            if (!(FAST)) { \
                float ma = __builtin_fmaxf(__builtin_fmaxf(C0[0], C0[1]), C1[0]), mb = __builtin_fmaxf(__builtin_fmaxf(C0[2], C0[3]), C1[1]); \
                ma = __builtin_fmaxf(__builtin_fmaxf(ma, C1[2]), C1[3]); \
                _Pragma("unroll") for (int r = 4; r < 16; r += 4) { ma = __builtin_fmaxf(__builtin_fmaxf(ma, C0[r]), C0[r + 1]); mb = __builtin_fmaxf(__builtin_fmaxf(mb, C0[r + 2]), C0[r + 3]); \
                    ma = __builtin_fmaxf(__builtin_fmaxf(ma, C1[r]), C1[r + 1]); mb = __builtin_fmaxf(__builtin_fmaxf(mb, C1[r + 2]), C1[r + 3]); } \
                float mx = __builtin_fmaxf(ma, mb); mx = __builtin_fmaxf(mx, swap32_other(mx, hi)); \
                if (__builtin_expect(__ballot(mx > 20.0f) != 0ull, 0)) { \
                    const float dl = __builtin_fmaxf(mx, 0.f); mref += dl; \
                    _Pragma("unroll") for (int r = 0; r < 16; ++r) { C0[r] -= dl; C1[r] -= dl; } \
                    const float alpha = __builtin_amdgcn_exp2f(-dl); \
                    _Pragma("unroll") for (int r = 0; r < 16; ++r) { o0[r] *= alpha; o1[r] *= alpha; o2[r] *= alpha; } \
                } } \
            if (HASNEXT) { if (((t + 1) & 3) == 0) AT_CBIAS(t + 1); AT_QK(N0, N1, (t + 1) & 1); } \
            _Pragma("unroll") for (int r = 0; r < 16; ++r) { C0[r] = __builtin_amdgcn_exp2f(C0[r]); C1[r] = __builtin_amdgcn_exp2f(C1[r]); } \
            _Pragma("unroll") for (int s = 0; s < 4; ++s) { \
                u32x4 pw; \
                if (s == 0) pw = (u32x4){cvtpk(C0[0], C0[1]), cvtpk(C0[2], C0[3]), cvtpk(C0[4], C0[5]), cvtpk(C0[6], C0[7])}; \
                else if (s == 1) pw = (u32x4){cvtpk(C0[8], C0[9]), cvtpk(C0[10], C0[11]), cvtpk(C0[12], C0[13]), cvtpk(C0[14], C0[15])}; \
                else if (s == 2) pw = (u32x4){cvtpk(C1[0], C1[1]), cvtpk(C1[2], C1[3]), cvtpk(C1[4], C1[5]), cvtpk(C1[6], C1[7])}; \
                else pw = (u32x4){cvtpk(C1[8], C1[9]), cvtpk(C1[10], C1[11]), cvtpk(C1[12], C1[13]), cvtpk(C1[14], C1[15])}; \
                const bf16x8 pa = __builtin_bit_cast(bf16x8, pw); \
                const LAS char* vp = vb + vlane + (16 * s) * VS; \
                const v4i16_t a0 = vtr(vp), a1 = vtr(vp + 8 * VS), b0 = vtr(vp + 64), b1 = vtr(vp + 8 * VS + 64); \
                const bf16x8 va = (bf16x8){a0[0], a0[1], a0[2], a0[3], a1[0], a1[1], a1[2], a1[3]}; \
                const bf16x8 vb8 = (bf16x8){b0[0], b0[1], b0[2], b0[3], b1[0], b1[1], b1[2], b1[3]}; \
                o0 = __builtin_amdgcn_mfma_f32_32x32x16_bf16(va, pa, o0, 0, 0, 0); \
                o1 = __builtin_amdgcn_mfma_f32_32x32x16_bf16(vb8, pa, o1, 0, 0, 0); \
                o2 = __builtin_amdgcn_mfma_f32_32x32x16_bf16(onesf, pa, o2, 0, 0, 0); \
            } \
            if (t + 2 < nt) AT_STK(t & 1); \
            if (t + 1 < nt) AT_STV((t + 1) & 1); \
            asm volatile("s_waitcnt lgkmcnt(0)" ::: "memory"); __builtin_amdgcn_s_barrier(); asm volatile("" ::: "memory");     \
        } while (0)
        int t = 0;
        if (fast) {
            for (; t < nt - 2; ) { AT_STEP(true, true, pa0, pa1, pb0, pb1); ++t; AT_STEP(true, true, pb0, pb1, pa0, pa1); ++t; }
            AT_STEP(true, true, pa0, pa1, pb0, pb1); ++t; AT_STEP(false, true, pb0, pb1, pa0, pa1);
        } else {
            for (; t < nt - 2; ) { AT_STEP(true, false, pa0, pa1, pb0, pb1); ++t; AT_STEP(true, false, pb0, pb1, pa0, pa1); ++t; }
            AT_STEP(true, false, pa0, pa1, pb0, pb1); ++t; AT_STEP(false, false, pb0, pb1, pa0, pa1);
        }
#undef AT_STEP
        const float lv = o2[0], lo_ = swap32_other(lv, hi), ltot = hi ? lo_ : lv, inv = 1.f / ltot;
        bf16_t* orow = O + (size_t)qrow * ldo + 4 * hi;
#pragma unroll
        for (int g4 = 0; g4 < 4; ++g4) {
            u32x2 w0, w1;
            w0.x = cvtpk(o0[4 * g4] * inv, o0[4 * g4 + 1] * inv); w0.y = cvtpk(o0[4 * g4 + 2] * inv, o0[4 * g4 + 3] * inv);
            w1.x = cvtpk(o1[4 * g4] * inv, o1[4 * g4 + 1] * inv); w1.y = cvtpk(o1[4 * g4 + 2] * inv, o1[4 * g4 + 3] * inv);
            *(u32x2*)(orow + 8 * g4) = w0; *(u32x2*)(orow + 32 + 8 * g4) = w1;
        }
    }
    __builtin_amdgcn_s_setprio(0);
#undef AT_LOADK
#undef AT_LOADV
#undef AT_STK
#undef AT_STV
#undef AT_QK
#undef AT_CBIAS
}

#define XB_TMO      128
#define XB_XCNT(j)  (256  + 64 * (j))
#define XB_XSUB(j)  (1280 + 64 * (j))
#define XB_XGEN(j)  (2304 + 64 * (j))
#define XB_TOP      3328
#define XB_TOPGEN   3392
#define XCD_BAR_WORDS 3456
#define XB_SPIN_CAP (1u << 18)
__device__ __forceinline__ unsigned xb_ld(unsigned* p)              { return __hip_atomic_load(p, __ATOMIC_RELAXED, __HIP_MEMORY_SCOPE_AGENT); }
__device__ __forceinline__ unsigned xb_add(unsigned* p, unsigned v) { return __hip_atomic_fetch_add(p, v, __ATOMIC_RELAXED, __HIP_MEMORY_SCOPE_AGENT); }
__device__ __forceinline__ unsigned xb_xcc_id() { return (unsigned)__builtin_amdgcn_s_getreg((3 << 11) | 20) & 0xFu; }
#define XB_SPIN(cond, bar) do { unsigned _sp = 0; while (cond) { __builtin_amdgcn_s_sleep(1); \
    if ((++_sp & 255u) == 0u) { if (xb_ld(&(bar)[XB_TMO])) break; if (_sp > XB_SPIN_CAP) { atomicAdd(&(bar)[XB_TMO], 1u); break; } } } } while (0)
struct XcdBarrier { unsigned* bar; unsigned x; volatile LAS unsigned* st; };
__device__ __forceinline__ XcdBarrier xcd_barrier_post(unsigned* bar, volatile LAS unsigned* st) {
    XcdBarrier b; b.bar = bar; b.x = xb_xcc_id(); b.st = st;
    if (threadIdx.x == 0) (void)xb_add(&bar[XB_XCNT(b.x)], 1u);
    return b;
}
__device__ __forceinline__ void xcd_barrier_complete(unsigned* bar, unsigned x, unsigned& nloc, unsigned& nx) {
    const unsigned G = gridDim.x * gridDim.y * gridDim.z;
    unsigned sum, cnt, mine, sp = 0u;
    for (;;) {
        sum = 0u; cnt = 0u; mine = 0u;
#pragma unroll
        for (unsigned j = 0; j < 16; ++j) { const unsigned c = xb_ld(&bar[XB_XCNT(j)]); sum += c; cnt += (c > 0u) ? 1u : 0u; mine = (j == x) ? c : mine; }
        if (sum == G) break;
        __builtin_amdgcn_s_sleep(1);
        if ((++sp & 255u) == 0u) { if (xb_ld(&bar[XB_TMO])) break; if (sp > XB_SPIN_CAP) { atomicAdd(&bar[XB_TMO], 1u); break; } }
    }
    nloc = mine > 0u ? mine : 1u; nx = cnt > 0u ? cnt : 1u;
}
__device__ __forceinline__ void xcd_barrier(const XcdBarrier& b, const int wv) {
    asm volatile("s_waitcnt vmcnt(0)" ::: "memory");
    __syncthreads();
    const int t0 = tid_of(wv);
    if (t0 == 0) {
        unsigned* bar = b.bar;
        __builtin_amdgcn_s_waitcnt(0);
        unsigned nloc = b.st[0], nx = b.st[1];
        if (nloc == 0u) { xcd_barrier_complete(bar, b.x, nloc, nx); b.st[0] = nloc; b.st[1] = nx; }
        const unsigned old = xb_add(&bar[XB_XSUB(b.x)], 1u);
        const unsigned gen = old / nloc;
        if (old + 1u == (gen + 1u) * nloc) {
            __builtin_amdgcn_fence(__ATOMIC_RELEASE, "agent");
            asm volatile("s_waitcnt vmcnt(0)" ::: "memory");
            const unsigned og = xb_add(&bar[XB_TOP], 1u);
            const unsigned tg = og / nx;
            if (og + 1u == (tg + 1u) * nx) xb_add(&bar[XB_TOPGEN], 1u);
            else XB_SPIN(xb_ld(&bar[XB_TOPGEN]) == tg, bar);
            __builtin_amdgcn_fence(__ATOMIC_ACQUIRE, "agent");
            xb_add(&bar[XB_XGEN(b.x)], 1u);
            asm volatile("s_waitcnt vmcnt(0)" ::: "memory");
        } else {
            XB_SPIN(xb_ld(&bar[XB_XGEN(b.x)]) == gen, bar);
            __builtin_amdgcn_fence(__ATOMIC_ACQUIRE, "agent");
            asm volatile("s_waitcnt vmcnt(0)" ::: "memory");
        }
    }
    __syncthreads();
}

__device__ __forceinline__ int obid() { int b = blockIdx.x; asm volatile("" : "+s"(b)); return b; }
struct Args { const float* in[24]; float* out; unsigned char* ws; };
constexpr int ARGTBL_OFF = 139264;
struct Tbl {
    const LAS unsigned* t;
    __device__ __forceinline__ unsigned long long q(int i) const { const LAS unsigned* p = t; asm volatile("" : "+v"(p)); const unsigned lo = __builtin_amdgcn_readfirstlane(p[2 * i]), hi = __builtin_amdgcn_readfirstlane(p[2 * i + 1]); return ((unsigned long long)hi << 32) | lo; }
    __device__ __forceinline__ const float* in(int i) const { return (const float*)(const __attribute__((address_space(1))) float*)q(i); }
    __device__ __forceinline__ float* out() const { return (float*)(__attribute__((address_space(1))) float*)q(24); }
    __device__ __forceinline__ unsigned char* ws() const { return (unsigned char*)(__attribute__((address_space(1))) unsigned char*)q(25); }
};

__device__ __forceinline__ void tr_item(const float* __restrict__ W, int N, bf16_t* __restrict__ WT, int ldt, int drow0, LAS float* scr, int k0, int n0, int lane, const float* __restrict__ gk) {
#pragma unroll
    for (int i = 0; i < 32; ++i) { const int kk = 2 * i + (lane >> 5); scr[kk * 33 + (lane & 31)] = W[(size_t)(k0 + kk) * N + n0 + (lane & 31)] * (gk ? gk[k0 + kk] : 1.f); }
    asm volatile("s_waitcnt lgkmcnt(0)" ::: "memory");
    const int c = lane & 7;
#pragma unroll
    for (int j = 0; j < 4; ++j) { const int n = (lane >> 3) + 8 * j; const LAS float* s = scr + (8 * c) * 33 + n;
        u32x4 o; o.x = pk2(s[0], s[33]); o.y = pk2(s[2 * 33], s[3 * 33]); o.z = pk2(s[4 * 33], s[5 * 33]); o.w = pk2(s[6 * 33], s[7 * 33]);
        *(u32x4*)(WT + (size_t)(drow0 + n) * ldt + k0 + 8 * c) = o; }
    asm volatile("s_waitcnt lgkmcnt(0)" ::: "memory");
}
__device__ __forceinline__ void tr_matrix(const float* W, int K, int N, bf16_t* WT, int ldt, int mode, LAS float* scr, int gw, int ngw, int lane, int& base, const float* gk = nullptr) {
    const int nblk = N / 32, nitems = (K / 64) * nblk;
    const int first = (gw - base % ngw + ngw) % ngw;
    base += nitems;
    for (int it = first; it < nitems; it += ngw) { const int kb = it / nblk, nb = it % nblk, n0 = 32 * nb;
        int drow0 = n0;
        if (mode == 1) { const int nn = n0 & 1023; drow0 = 256 * (nn >> 7) + (nn & 127) + ((n0 >> 10) ? 128 : 0); }
        tr_item(W, N, WT, ldt, drow0, scr, 64 * kb, n0, lane, gk); }
}

__device__ __forceinline__ void s5_prep(const Tbl a, int layer_i, int grp, LAS char* lds, const int part) {
    LAS f32x2* apow = (LAS f32x2*)lds;
    LAS f32x2* bb = apow + 17 * 64;
    LAS f32x2* cc = bb + 64 * 16;
    LAS float* ker = (LAS float*)(cc + 16 * 64);
    const int tid = threadIdx.x;
    const float* lam_re = a.in(13) + (size_t)(layer_i * 64 + grp) * 64; const float* lam_im = a.in(14) + (size_t)(layer_i * 64 + grp) * 64;
    const float dt = expf(a.in(15)[layer_i * 64 + grp]);
    const float* b_re = a.in(16) + (size_t)(layer_i * 64 + grp) * 1024; const float* b_im = a.in(17) + (size_t)(layer_i * 64 + grp) * 1024;
    const float* c_re = a.in(18) + (size_t)(layer_i * 64 + grp) * 1024; const float* c_im = a.in(19) + (size_t)(layer_i * 64 + grp) * 1024;
    const float* dsk = a.in(20) + (size_t)layer_i * DM + grp * 16;
    for (int e = tid; e < 17 * 64; e += 512) { const int m = e >> 6, p = e & 63; const float lr = lam_re[p], li = lam_im[p];
        const float mag = expf(lr * dt * (float)m); float rev = (li * dt * (float)m) * 0.15915494309189535f; rev -= rintf(rev);
        apow[e] = (f32x2){mag * __builtin_amdgcn_cosf(rev), mag * __builtin_amdgcn_sinf(rev)}; }
    __syncthreads();
    for (int e = tid; e < 1024; e += 512) { const int p = e >> 4; const float lr = lam_re[p], li = lam_im[p];
        const f32x2 a1 = apow[64 + p]; const float nr = a1.x - 1.f, ni = a1.y, den = 1.f / (lr * lr + li * li);
        const float cr = (nr * lr + ni * li) * den, ci = (ni * lr - nr * li) * den;
        const float br = b_re[e], bi = b_im[e]; bb[e] = (f32x2){cr * br - ci * bi, cr * bi + ci * br}; }
    if (part == 0 && tid < 64) { float* A16 = (float*)(a.ws() + WS_A16) + (size_t)((layer_i * 64 + grp) * 64 + tid) * 2; A16[0] = apow[16 * 64 + tid].x; A16[1] = apow[16 * 64 + tid].y; }
    if (part == 1) for (int e = tid; e < 1024; e += 512) cc[e] = (f32x2){c_re[e], c_im[e]};
    __syncthreads();
    if (part == 1) {
    for (int e = tid; e < 4096; e += 512) { const int m = e >> 8, o = (e >> 4) & 15, i = e & 15; float s = 0.f;
        for (int p = 0; p < 64; ++p) { const f32x2 c = cc[o * 64 + p], ap = apow[m * 64 + p], b = bb[p * 16 + i];
            const float tr = c.x * ap.x - c.y * ap.y, ti = c.x * ap.y + c.y * ap.x; s += tr * b.x - ti * b.y; }
        if (m == 0 && o == i) s += dsk[o];
        ker[e] = s; }
    __syncthreads();
    bf16_t* BtB = (bf16_t*)(a.ws() + WS_S5B) + (size_t)(layer_i * 64 + grp) * 256 * S5K;
    for (int ch = tid; ch < 256 * 48; ch += 512) { const int n = ch / 48, kc = ch % 48, l = n >> 4, o = n & 15, k0 = kc * 8; float v[8];
        if (k0 < 256) { const int j = k0 >> 4, i0 = k0 & 15;
#pragma unroll
            for (int e = 0; e < 8; ++e) v[e] = (l >= j) ? ker[((l - j) * 16 + o) * 16 + i0 + e] : 0.f; }
        else {
#pragma unroll
            for (int e = 0; e < 8; ++e) { const int kk = k0 - 256 + e, p = kk >> 1; const f32x2 c = cc[o * 64 + p], ap = apow[(l + 1) * 64 + p];
                v[e] = (kk & 1) ? -(c.x * ap.y + c.y * ap.x) : (c.x * ap.x - c.y * ap.y); } }
        u32x4 w; w.x = pk2(v[0], v[1]); w.y = pk2(v[2], v[3]); w.z = pk2(v[4], v[5]); w.w = pk2(v[6], v[7]);
        *(u32x4*)(BtB + (size_t)n * S5K + k0) = w; }
    } else {
    bf16_t* BtA = (bf16_t*)(a.ws() + WS_S5A) + (size_t)(layer_i * 64 + grp) * 256 * 256;
    for (int ch = tid; ch < 256 * 32; ch += 512) { const int n = ch >> 5, kc = ch & 31, k0 = kc * 8, j = k0 >> 4, i0 = k0 & 15; float v[8];
        if (n < 128) { const int p = n >> 1; const f32x2 ap = apow[(15 - j) * 64 + p];
#pragma unroll
            for (int e = 0; e < 8; ++e) { const f32x2 b = bb[p * 16 + i0 + e]; v[e] = (n & 1) ? (ap.x * b.y + ap.y * b.x) : (ap.x * b.x - ap.y * b.y); } }
        else {
#pragma unroll
            for (int e = 0; e < 8; ++e) v[e] = 0.f; }
        u32x4 w; w.x = pk2(v[0], v[1]); w.y = pk2(v[2], v[3]); w.z = pk2(v[4], v[5]); w.w = pk2(v[6], v[7]);
        *(u32x4*)(BtA + (size_t)n * 256 + k0) = w; }
    }
    __syncthreads();
}

__device__ __forceinline__ void cast_rows(const float* __restrict__ x, bf16_t* __restrict__ xb, float* __restrict__ rowss, int gw, int ngw, int lane) {
    asm volatile("" : "+v"(lane)); asm volatile("" : "+s"(gw));
    for (int m = gw; m < MTOK; m += ngw) {
        const f32x4* xr = (const f32x4*)(x + (size_t)m * DM) + lane; f32x4 v[4]; float s = 0.f;
#pragma unroll
        for (int j = 0; j < 4; ++j) { v[j] = xr[64 * j]; s += (v[j].x * v[j].x + v[j].y * v[j].y) + (v[j].z * v[j].z + v[j].w * v[j].w); }
        s = wave_sum(s, lane);
        u32x2* o8 = (u32x2*)(xb + (size_t)m * DM) + lane;
#pragma unroll
        for (int j = 0; j < 4; ++j) { u32x2 w; w.x = cvtpk(v[j].x, v[j].y); w.y = cvtpk(v[j].z, v[j].w); o8[64 * j] = w; }
        if (lane == 0) rowss[m] = rsqrtf(s * (1.f / DM) + EPS);
    }
}
__device__ __forceinline__ void norm_rows_s5(const bf16_t* __restrict__ xb, const float* __restrict__ rowss, int nslots, const float* __restrict__ g, bf16_t* __restrict__ A2, int gw, int ngw, int lane) {
    asm volatile("" : "+v"(lane)); asm volatile("" : "+s"(gw));
    float gv[16];
#pragma unroll
    for (int j = 0; j < 4; ++j) { const f32x4 t = ((const f32x4*)g)[4 * lane + j]; gv[4 * j] = t.x; gv[4 * j + 1] = t.y; gv[4 * j + 2] = t.z; gv[4 * j + 3] = t.w; }
    for (int m = gw; m < MTOK; m += ngw) {
        const u32x4* xr = (const u32x4*)(xb + (size_t)m * DM) + 2 * lane; float v[16];
        unpack8(xr[0], v); unpack8(xr[1], v + 8);
        float sp = ((lane & 31) < nslots) ? rowss[(size_t)m * 32 + (lane & 31)] : 0.f;
#pragma unroll
        for (int o = 1; o < 32; o <<= 1) sp += shx(sp, o, lane);
        const float rs = rsqrtf(sp * (1.f / DM) + EPS);
#pragma unroll
        for (int e = 0; e < 16; ++e) v[e] = v[e] * rs * gv[e];
        const int b = m >> 12, t = m & 4095, c = t >> 4, jj = t & 15;
        u32x4* dst = (u32x4*)(A2 + ((size_t)lane * 4096 + b * 256 + c) * S5K + jj * 16);
        dst[0] = pack8(v); dst[1] = pack8(v + 8);
    }
}

__device__ __forceinline__ void p_lat(const Tbl a, int li, bf16_t* PROJ, int gw, int ngw, int lane) {
    asm volatile("" : "+v"(lane)); asm volatile("" : "+s"(gw));
    int seg0, slen, sdim; const float* gp = a.in(4); float extra = 1.f;
    if (lane < 8) { seg0 = 0; slen = 8; sdim = 256; gp = a.in(4) + li * 256 + 32 * lane; }
    else if (lane < 12) { seg0 = 8; slen = 4; sdim = 128; gp = a.in(6) + li * 128 + 32 * (lane - 8); }
    else if (lane == 12) { seg0 = 12; slen = 1; sdim = 32; }
    else if (lane < 29) { seg0 = 13 + ((lane - 13) & ~1); slen = 2; sdim = 64; gp = a.in(10) + li * 64 + 32 * ((lane - 13) & 1); extra = 0.125f * LOG2E; }
    else if (lane < 45) { seg0 = 29 + ((lane - 29) & ~1); slen = 2; sdim = 64; gp = a.in(11) + li * 64 + 32 * ((lane - 29) & 1); }
    else { seg0 = lane; slen = 1; sdim = 32; }
    const f32x2* rope = (const f32x2*)(a.ws() + WS_ROPE);
    u32x4 nx[4];
#pragma unroll
    for (int q = 0; q < 4; ++q) nx[q] = (u32x4){0, 0, 0, 0};
    if (lane < 45 && gw < MTOK) {
#pragma unroll
        for (int q = 0; q < 4; ++q) nx[q] = ((const u32x4*)(PROJ + (size_t)gw * INP + 32 * lane))[q]; }
    for (int m = gw; m < MTOK; m += ngw) {
        u32x4* rp = (u32x4*)(PROJ + (size_t)m * INP + 32 * lane);
        float v[32];
#pragma unroll
        for (int q = 0; q < 4; ++q) unpack8(nx[q], v + 8 * q);
        if (lane < 45 && m + ngw < MTOK) {
#pragma unroll
            for (int q = 0; q < 4; ++q) nx[q] = ((const u32x4*)(PROJ + (size_t)(m + ngw) * INP + 32 * lane))[q]; }
        float ss = 0.f;
#pragma unroll
        for (int e = 0; e < 32; ++e) ss += v[e] * v[e];
        float tot = 0.f;
#pragma unroll
        for (int k = 0; k < 8; ++k) { const float o = bperm((seg0 + k) & 63, ss); if (k < slen) tot += o; }
        if (lane == 12) { const f32x2* rr = rope + (size_t)(m & 4095) * 16;
#pragma unroll
            for (int i = 0; i < 16; ++i) { const f32x2 cs = rr[i]; const float x1 = v[i], x2 = v[16 + i]; v[i] = x1 * cs.x - x2 * cs.y; v[16 + i] = x1 * cs.y + x2 * cs.x; } }
        else if (lane < 45) { const float sc = rsqrtf(tot / (float)sdim + EPS) * extra;
#pragma unroll
            for (int e = 0; e < 32; ++e) v[e] = v[e] * sc * gp[e]; }
        if (lane < 45) {
#pragma unroll
            for (int q = 0; q < 4; ++q) rp[q] = pack8(v + 8 * q); }
    }
}

__device__ __forceinline__ void p_qk(const Tbl a, int li, const bf16_t* PROJ, bf16_t* QR, const bf16_t* KVR, bf16_t* KM, int gw, int ngw, int lane) {
    asm volatile("" : "+v"(lane)); asm volatile("" : "+s"(gw));
    const int h = lane / 6, j = lane - 6 * h; const bool act = lane < 48;
    const int d0 = j < 4 ? 16 * j : 64 + 8 * (j - 4), d1 = j < 4 ? 16 * j + 8 : 80 + 8 * (j - 4);
    const float* gq = a.in(8) + li * 96; const float* gk = a.in(9) + li * 96;
    const f32x2* rope = (const f32x2*)(a.ws() + WS_ROPE);
    const float qscale = 0.10206207261596577f * LOG2E;
    const bf16_t* kb0 = j < 4 ? KVR + 128 * h + d0 : PROJ + C_KR + (d0 - 64); const bf16_t* kb1 = j < 4 ? KVR + 128 * h + d1 : PROJ + C_KR + (d1 - 64);
    const size_t kpitch = j < 4 ? 1024 : INP;
    u32x4 nq0 = (u32x4){0, 0, 0, 0}, nq1 = nq0, nk0 = nq0, nk1 = nq0;
    if (act && gw < MTOK) { nq0 = *(const u32x4*)(QR + (size_t)gw * 768 + 96 * h + d0); nq1 = *(const u32x4*)(QR + (size_t)gw * 768 + 96 * h + d1);
        nk0 = *(const u32x4*)(kb0 + (size_t)gw * kpitch); nk1 = *(const u32x4*)(kb1 + (size_t)gw * kpitch); }
    for (int m = gw; m < MTOK; m += ngw) {
        float q0[8], q1[8], k0[8], k1[8];
        if (act) {
            unpack8(nq0, q0); unpack8(nq1, q1); unpack8(nk0, k0); unpack8(nk1, k1);
            if (m + ngw < MTOK) { const size_t mn = (size_t)(m + ngw);
                nq0 = *(const u32x4*)(QR + mn * 768 + 96 * h + d0); nq1 = *(const u32x4*)(QR + mn * 768 + 96 * h + d1);
                nk0 = *(const u32x4*)(kb0 + mn * kpitch); nk1 = *(const u32x4*)(kb1 + mn * kpitch); }
            if (j >= 4) { const f32x2* rr = rope + (size_t)(m & 4095) * 16 + 8 * (j - 4);
#pragma unroll
                for (int e = 0; e < 8; ++e) { const f32x2 cs = rr[e]; const float x1 = q0[e], x2 = q1[e]; q0[e] = x1 * cs.x - x2 * cs.y; q1[e] = x1 * cs.y + x2 * cs.x; } }
        } else {
#pragma unroll
            for (int e = 0; e < 8; ++e) { q0[e] = q1[e] = k0[e] = k1[e] = 0.f; } }
        float sq = 0.f, sk = 0.f;
#pragma unroll
        for (int e = 0; e < 8; ++e) { sq += q0[e] * q0[e] + q1[e] * q1[e]; sk += k0[e] * k0[e] + k1[e] * k1[e]; }
        float tq = 0.f, tk = 0.f;
#pragma unroll
        for (int k = 0; k < 6; ++k) { const int src = (6 * h + k) & 63; tq += bperm(src, sq); tk += bperm(src, sk); }
        if (act) {
            const float scq = rsqrtf(tq * (1.f / 96.f) + EPS) * qscale, sck = rsqrtf(tk * (1.f / 96.f) + EPS);
#pragma unroll
            for (int e = 0; e < 8; ++e) { q0[e] *= scq * gq[d0 + e]; q1[e] *= scq * gq[d1 + e]; k0[e] *= sck * gk[d0 + e]; k1[e] *= sck * gk[d1 + e]; }
            *(u32x4*)(QR + (size_t)m * 768 + 96 * h + d0) = pack8(q0); *(u32x4*)(QR + (size_t)m * 768 + 96 * h + d1) = pack8(q1);
            *(u32x4*)(KM + (size_t)m * 768 + 96 * h + d0) = pack8(k0); *(u32x4*)(KM + (size_t)m * 768 + 96 * h + d1) = pack8(k1);
        }
    }
}

#define ws (a.ws())
#define out (a.out())
#define XN ((bf16_t*)(ws + WS_XN))
#define OB ((bf16_t*)(ws + WS_OB))
#define ROWSS(i) ((float*)(ws + WS_ROWSS) + (size_t)((i) & 1) * MTOK * 32)
#define RSV(i) ((float*)(ws + WS_RS) + (size_t)((i) & 1) * MTOK)
#define FINALIZE_RS(i, ns) do { const int t_ = tid_of(wave); for (int r_ = obid() * 512 + t_; r_ < MTOK; r_ += G * 512) RSV(i)[r_] = row_rs(ROWSS(i), r_, ns); GSYNC(); } while (0)
#define PROJ ((bf16_t*)(ws + WS_PROJ))
#define QR ((bf16_t*)(ws + WS_QR))
#define KVR ((bf16_t*)(ws + WS_KVR))
#define KM ((bf16_t*)(ws + WS_KM))
#define HID ((bf16_t*)(ws + WS_HID))
#define A2 ((bf16_t*)(ws + WS_A2))
#define XS ((bf16_t*)(ws + WS_XS))
#define GS ((bf16_t*)(ws + WS_GS))
#define KMEAN ((bf16_t*)(ws + WS_KMEAN))

#define GSYNC() do { const XcdBarrier xb_{(unsigned*)ws, xb_xcc_id(), (volatile LAS unsigned*)(lds + ARGTBL_OFF + 256)}; xcd_barrier(xb_, wave); } while (0)
template <int layer>
__device__ __forceinline__ void run_layer(const Tbl a, LAS unsigned char* lds, const int G, const int wave) {
    const int tid = tid_of(wave);
    const int lane = tid & 63;
    const int gw = obid() * 8 + wave, ngw = G * 8;
    pg8::StaticOrder S;
        const int li = layer >> 1;
        if ((layer & 1) == 0) {
            { pg8::Gemm g{XN, (const bf16_t*)(ws + WS_WIN) + (size_t)li * INP * DM, MTOK, INP, DM, DM, DM, -1, 0}; S.init(MTOK, INP, G, obid());
              EpiBf16<0, 2> E{PROJ, INP, RSV(2 * layer), 0}; pg8::gemm_phase(lds, g, S, E, wave); }
            GSYNC();
            p_lat(a, li, PROJ, gw, ngw, lane);
            GSYNC();
            { pg8::Gemm g{PROJ + C_CQ, (const bf16_t*)(ws + WS_WUQ) + (size_t)li * 768 * 256, MTOK, 768, 256, INP, 256, -1, 0}; S.init(MTOK, 768, G, obid());
              EpiBf16<0, 2> E{QR, 768, nullptr, 0}; pg8::gemm_phase(lds, g, S, E, wave); }
            { pg8::Gemm g{PROJ + C_CKV, (const bf16_t*)(ws + WS_WUKV) + (size_t)li * 1024 * 128, MTOK, 1024, 128, INP, 128, -1, 0}; S.init(MTOK, 1024, G, obid());
              EpiBf16<0, 2> E{KVR, 1024, nullptr, 0}; pg8::gemm_phase(lds, g, S, E, wave); }
            GSYNC();
            p_qk(a, li, PROJ, QR, KVR, KM, gw, ngw, lane);
            for (int c = obid(); c < 256; c += G) {
                const int tid = tid_of(wave); const int lane = tid & 63;
                const int b = c >> 4, blk = c & 15; LAS float* red = (LAS float*)lds;
                float s8[8];
#pragma unroll
                for (int e = 0; e < 8; ++e) s8[e] = 0.f;
                for (int r = 0; r < 32; ++r) { float f[8]; unpack8(*(const u32x4*)(PROJ + (size_t)(b * SEQ + blk * 256 + wave * 32 + r) * INP + C_KB + 8 * lane), f);
#pragma unroll
                    for (int e = 0; e < 8; ++e) s8[e] += f[e]; }
#pragma unroll
                for (int e = 0; e < 8; ++e) red[wave * 512 + 8 * lane + e] = s8[e];
                __syncthreads();
                { float s = 0.f;
#pragma unroll
                  for (int w = 0; w < 8; ++w) s += red[w * 512 + tid];
                  KMEAN[((size_t)(b * 8 + (tid >> 6)) * 16 + blk) * 64 + (tid & 63)] = (bf16_t)f2bf(s * (1.f / 256.f)); }
                __syncthreads();
            }
            GSYNC();
            for (int c = obid(); c < 256; c += G) {
                const int xcd = c & 7, j = c >> 3, side = j & 1, h = (j >> 1) & 7, b = 2 * xcd + (j >> 4); const size_t r0 = (size_t)b * SEQ;
                const unsigned m0 = 0x9999u;
                const unsigned qm_mla = side ? (~m0 & 0xffffu) : m0, qm_moba = side ? m0 : (~m0 & 0xffffu);
                attn_head<96, false>(QR + r0 * 768 + 96 * h, 768, KM + r0 * 768 + 96 * h, 768, KVR + r0 * 1024 + 128 * h + 64, 1024, OB + r0 * DM + 64 * h, DM, nullptr, (LAS char*)lds, qm_mla, wave, ((const int*)(ws + WS_FLAGS))[li * 2] != 0);
                attn_head<64, true>(PROJ + r0 * INP + C_QB + 64 * h, INP, PROJ + r0 * INP + C_KB + 64 * h, INP, PROJ + r0 * INP + C_VB + 64 * h, INP, OB + r0 * DM + 512 + 64 * h, DM,
                                    KMEAN + (size_t)(b * 8 + h) * 16 * 64, (LAS char*)lds, qm_moba, wave, ((const int*)(ws + WS_FLAGS))[li * 2 + 1] != 0);
            }
            GSYNC();
            { pg8::Gemm g{OB, (const bf16_t*)(ws + WS_WO) + (size_t)li * DM * DM, MTOK, DM, DM, DM, DM, -1, 0}; S.init(MTOK, DM, G, obid());
              EpiResid E{XN, ROWSS(2 * layer + 1), nullptr}; pg8::gemm_phase(lds, g, S, E, wave); }
            GSYNC();
            FINALIZE_RS(2 * layer + 1, 16);
        } else {
            norm_rows_s5(XN, ROWSS(2 * layer), 16, a.in(1) + layer * DM, A2, gw, ngw, lane);
            GSYNC();
            { pg8::Gemm g{A2, (const bf16_t*)(ws + WS_S5A) + (size_t)li * 64 * 256 * 256, S5ROWS, 256, 256, S5K, 256, 4, 0}; S.init(S5ROWS, 256, G, obid());
              EpiBf16<0, 1> E{XS, 128, nullptr, 0}; pg8::gemm_phase(lds, g, S, E, wave); }
            GSYNC();
            const int tid_s = tid_of(wave);
            for (int idx = obid() * 512 + tid_s; idx < 65536; idx += G * 512) {
                const int p = idx & 63, b = (idx >> 6) & 15, grp = idx >> 10;
                const float* A16 = (const float*)(ws + WS_A16) + (size_t)((li * 64 + grp) * 64 + p) * 2; const float ar = A16[0], ai = A16[1];
                const size_t r0 = (size_t)grp * 4096 + b * 256; float hr = 0.f, hi_ = 0.f;
                const unsigned* XS32 = (const unsigned*)XS; unsigned* A232 = (unsigned*)A2;
                for (int c0 = 0; c0 < 256; c0 += 32) { unsigned xw[32];
#pragma unroll
                    for (int k = 0; k < 32; ++k) xw[k] = XS32[(r0 + c0 + k) * 64 + p];
#pragma unroll
                    for (int k = 0; k < 32; ++k) { A232[(r0 + c0 + k) * (S5K / 2) + 128 + p] = pk2(hr, hi_);
                        const float nr = ar * hr - ai * hi_ + bf_lo(xw[k]), ni = ar * hi_ + ai * hr + bf_hi(xw[k]); hr = nr; hi_ = ni; } }
            }
            GSYNC();
            { pg8::Gemm g{A2, (const bf16_t*)(ws + WS_S5B) + (size_t)li * 64 * 256 * S5K, S5ROWS, 256, S5K, S5K, S5K, 4, 0}; S.init(S5ROWS, 256, G, obid());
              EpiS5Y E{GS}; pg8::gemm_phase(lds, g, S, E, wave); }
            GSYNC();
            { pg8::Gemm g{GS, (const bf16_t*)(ws + WS_WGLU) + (size_t)li * 2048 * DM, MTOK, 2048, DM, 16, DM, -1, 1}; S.init(MTOK, 2048, G, obid());
              EpiGlu E{XN, ROWSS(2 * layer + 1)}; pg8::gemm_phase(lds, g, S, E, wave); }
            GSYNC();
            FINALIZE_RS(2 * layer + 1, 32);
        }
        { pg8::Gemm g{XN, (const bf16_t*)(ws + WS_W1) + (size_t)layer * DFF * DM, MTOK, DFF, DM, DM, DM, -1, 0}; S.init(MTOK, DFF, G, obid());
          EpiBf16<1, 2> E{HID, DFF, RSV(2 * layer + 1), 0}; pg8::gemm_phase(lds, g, S, E, wave); }
        GSYNC();
        { pg8::Gemm g{HID, (const bf16_t*)(ws + WS_W2) + (size_t)layer * DM * DFF, MTOK, DM, DFF, DFF, DFF, -1, 0}; S.init(MTOK, DM, G, obid());
          EpiResid E{XN, ROWSS(2 * layer + 2), (layer < DEPTH - 1) ? (float*)nullptr : out}; pg8::gemm_phase(lds, g, S, E, wave); }
        GSYNC();
        if (layer == 1) FINALIZE_RS(2 * layer + 2, 16);
    }

__global__ void __launch_bounds__(512, 2) fwd_mega(Args a_unused) {
    extern __shared__ __attribute__((aligned(16))) unsigned char lds_raw[];
    cg::grid_group grid = cg::this_grid();
    LAS unsigned char* lds = (LAS unsigned char*)lds_raw;
    {
        const unsigned __attribute__((address_space(4)))* kp = (const unsigned __attribute__((address_space(4)))*)__builtin_amdgcn_kernarg_segment_ptr();
        if (threadIdx.x < 52) ((LAS unsigned*)(lds + ARGTBL_OFF))[threadIdx.x] = kp[threadIdx.x];
        if (threadIdx.x >= 64 && threadIdx.x < 66) ((LAS unsigned*)(lds + ARGTBL_OFF + 256))[threadIdx.x - 64] = 0u;
        __syncthreads();
    }
    const Tbl a{(const LAS unsigned*)(lds + ARGTBL_OFF)};
    const int tid = threadIdx.x, lane = tid & 63, wave = __builtin_amdgcn_readfirstlane(tid >> 6);
    const int G = gridDim.x, gw = blockIdx.x * 8 + wave, ngw = G * 8;
    {
        if (blockIdx.x == 0) for (int e = threadIdx.x; e < XCD_BAR_WORDS; e += 512) __hip_atomic_store((unsigned*)ws + e, 0u, __ATOMIC_RELAXED, __HIP_MEMORY_SCOPE_AGENT);
        for (int it = blockIdx.x; it < 256; it += G) s5_prep(a, it >> 7, (it >> 1) & 63, (LAS char*)lds, it & 1);
        LAS float* scr = (LAS float*)(lds + wave * 16384);
        int trbase = 0;
        for (int i = 0; i < 2; ++i) {
            tr_matrix(a.in(3) + (size_t)i * DM * INC, DM, INC, (bf16_t*)(ws + WS_WIN) + (size_t)i * INP * DM, DM, 0, scr, gw, ngw, lane, trbase, a.in(1) + 2 * i * DM);
            tr_matrix(a.in(5) + (size_t)i * 256 * 768, 256, 768, (bf16_t*)(ws + WS_WUQ) + (size_t)i * 768 * 256, 256, 0, scr, gw, ngw, lane, trbase);
            tr_matrix(a.in(7) + (size_t)i * 128 * 1024, 128, 1024, (bf16_t*)(ws + WS_WUKV) + (size_t)i * 1024 * 128, 128, 0, scr, gw, ngw, lane, trbase);
            tr_matrix(a.in(12) + (size_t)i * DM * DM, DM, DM, (bf16_t*)(ws + WS_WO) + (size_t)i * DM * DM, DM, 0, scr, gw, ngw, lane, trbase);
            tr_matrix(a.in(21) + (size_t)i * DM * 2048, DM, 2048, (bf16_t*)(ws + WS_WGLU) + (size_t)i * 2048 * DM, DM, 1, scr, gw, ngw, lane, trbase);
        }
        for (int i = 0; i < DEPTH; ++i) {
            tr_matrix(a.in(22) + (size_t)i * DM * DFF, DM, DFF, (bf16_t*)(ws + WS_W1) + (size_t)i * DFF * DM, DM, 0, scr, gw, ngw, lane, trbase, a.in(2) + i * DM);
            tr_matrix(a.in(23) + (size_t)i * DFF * DM, DFF, DM, (bf16_t*)(ws + WS_W2) + (size_t)i * DM * DFF, DFF, 0, scr, gw, ngw, lane, trbase);
        }
        const int gt = blockIdx.x * 512 + tid, ngt = G * 512;
        for (int e = gt; e < 2 * (INP - INC) * DM / 8; e += ngt) {
            const int i = e / ((INP - INC) * DM / 8), r = e % ((INP - INC) * DM / 8);
            *(u32x4*)((bf16_t*)(ws + WS_WIN) + (size_t)i * INP * DM + (size_t)INC * DM + (size_t)r * 8) = (u32x4){0, 0, 0, 0}; }
        if (blockIdx.x == 1 % G && tid < 4) {
            const int li_ = tid >> 1, ty = tid & 1, d = ty ? 64 : 96; const float* gq = a.in(ty ? 10 : 8) + li_ * d; const float* gk = a.in(ty ? 11 : 9) + li_ * d;
            float mq = 0.f, mk = 0.f; for (int e = 0; e < d; ++e) { mq = fmaxf(mq, fabsf(gq[e])); mk = fmaxf(mk, fabsf(gk[e])); }
            ((int*)(ws + WS_FLAGS))[tid] = (sqrtf((float)d) * mq * mk * LOG2E < 64.f) ? 1 : 0; }
        cast_rows(a.in(0), XN, RSV(0), gw, ngw, lane);
        for (int e = gt; e < SEQ * 16; e += ngt) { const int pos = e >> 4, i = e & 15;
            const float inv = exp2f(-(float)i * (13.287712379549449f / 16.f)); float rev = ((float)pos * inv) * 0.15915494309189535f; rev -= rintf(rev);
            ((f32x2*)(ws + WS_ROPE))[e] = (f32x2){__builtin_amdgcn_cosf(rev), __builtin_amdgcn_sinf(rev)}; }
    }
    grid.sync();
    (void)xcd_barrier_post((unsigned*)ws, (volatile LAS unsigned*)(lds + ARGTBL_OFF + 256));

    run_layer<0>(a, lds, G, wave); run_layer<1>(a, lds, G, wave); run_layer<2>(a, lds, G, wave); run_layer<3>(a, lds, G, wave);
#undef ws
#undef out
#undef GSYNC
#undef FINALIZE_RS
}

extern "C" void kernel_launch(void* const* d_in, const int* in_sizes, int n_in, void* d_out, int out_size, void* d_ws, size_t ws_size, hipStream_t stream) {
    static int grid = 0;
    if (grid == 0) {
        if (n_in != 24 || out_size != MTOK * DM || ws_size < WS_END) { fprintf(stderr, "kernel_launch: unexpected shapes (n_in %d out %d ws %zu)\n", n_in, out_size, ws_size); grid = -1; return; }
        int dev = 0, cus = 0, per_cu = 0;
        hipGetDevice(&dev); hipDeviceGetAttribute(&cus, hipDeviceAttributeMultiprocessorCount, dev);
        hipFuncSetAttribute((const void*)fwd_mega, hipFuncAttributeMaxDynamicSharedMemorySize, LDS_BYTES);
        hipOccupancyMaxActiveBlocksPerMultiprocessor(&per_cu, (const void*)fwd_mega, 512, LDS_BYTES);
        if (per_cu < 1) { fprintf(stderr, "kernel_launch: occupancy query says %d blocks/CU\n", per_cu); per_cu = 1; }
        (void)hipGetLastError();
        grid = cus * 1;
    }
    if (grid < 0) return;
    Args a{};
    for (int i = 0; i < 24; ++i) a.in[i] = (const float*)d_in[i];
    a.out = (float*)d_out; a.ws = (unsigned char*)d_ws;
    void* args[] = {&a};
    hipError_t e = hipLaunchCooperativeKernel((const void*)fwd_mega, dim3(grid), dim3(512), args, LDS_BYTES, stream);
    if (e != hipSuccess) fprintf(stderr, "cooperative launch failed: %s (grid %d)\n", hipGetErrorString(e), grid);
}
```

```cpp
#include <hip/hip_runtime.h>
#include <hip/hip_cooperative_groups.h>
#include <cstdio>
#include <cstdint>
namespace cg = cooperative_groups;

#define LAS __attribute__((address_space(3)))
typedef unsigned short bf16_t;
typedef short bf16x8 __attribute__((ext_vector_type(8)));
typedef float f32x4 __attribute__((ext_vector_type(4)));
typedef float f32x16 __attribute__((ext_vector_type(16)));
typedef unsigned u32x4 __attribute__((ext_vector_type(4)));
typedef unsigned u32x2 __attribute__((ext_vector_type(2)));
typedef float f32x2 __attribute__((ext_vector_type(2)));

constexpr int DM = 1024, NB = 16, SEQ = 4096, MTOK = NB * SEQ, DEPTH = 4, DFF = 4096;
constexpr int INC = 1952, INP = 2048;
constexpr int C_CQ = 0, C_CKV = 256, C_KR = 384, C_QB = 416, C_KB = 928, C_VB = 1440;
constexpr float EPS = 1e-6f, LOG2E = 1.4426950408889634f;
constexpr int S5L = 16, S5NC = SEQ / S5L;
constexpr int S5ROWS = 64 * NB * S5NC;
constexpr int S5K = 384;

constexpr size_t MiB = 1u << 20;
constexpr size_t WS_WIN = 1 * MiB, WS_WUQ = 9 * MiB, WS_WUKV = 10 * MiB, WS_WO = 11 * MiB, WS_WGLU = 15 * MiB, WS_W1 = 23 * MiB, WS_W2 = 55 * MiB;
constexpr size_t WS_S5A = 87 * MiB, WS_S5B = 103 * MiB, WS_A16 = 127 * MiB, WS_ROPE = 128 * MiB, WS_KMEAN = 129 * MiB, WS_FLAGS = 129 * MiB + 512 * 1024;
constexpr size_t WS_XN = 130 * MiB;
constexpr size_t WS_BIG = 258 * MiB;
constexpr size_t WS_HID = WS_BIG, WS_PROJ = WS_BIG, WS_QR = WS_BIG + 256 * MiB, WS_KVR = WS_BIG + 352 * MiB;
constexpr size_t WS_A2 = WS_BIG, WS_XS = WS_BIG + 192 * MiB, WS_GS = WS_BIG + 256 * MiB;
constexpr size_t WS_KM = 770 * MiB, WS_OB = 866 * MiB, WS_ROWSS = 994 * MiB, WS_RS = 1010 * MiB, WS_END = 1011 * MiB;

constexpr int LDS_BYTES = 147456;

__device__ __forceinline__ unsigned f2bf(float f) { unsigned u = __builtin_bit_cast(unsigned, f); return (u + 0x7fffu + ((u >> 16) & 1u)) >> 16; }
__device__ __forceinline__ unsigned pk2(float lo, float hi) { return f2bf(lo) | (f2bf(hi) << 16); }
__device__ __forceinline__ unsigned cvtpk(float lo, float hi) { typedef __bf16 b2 __attribute__((ext_vector_type(2))); f32x2 v = {lo, hi}; b2 b = __builtin_convertvector(v, b2); return __builtin_bit_cast(unsigned, b); }
__device__ __forceinline__ float bf_lo(unsigned w) { return __builtin_bit_cast(float, w << 16); }
__device__ __forceinline__ float bf_hi(unsigned w) { return __builtin_bit_cast(float, w & 0xffff0000u); }
__device__ __forceinline__ int lane_id() { return (int)__builtin_amdgcn_mbcnt_hi(~0u, __builtin_amdgcn_mbcnt_lo(~0u, 0u)); }
__device__ __forceinline__ int tid_of(int wv) { int t = wv * 64 + lane_id(); asm volatile("" : "+v"(t)); return t; }
__device__ __forceinline__ float bperm(int srclane, float v) { return __builtin_bit_cast(float, __builtin_amdgcn_ds_bpermute(srclane << 2, __builtin_bit_cast(int, v))); }
__device__ __forceinline__ float shx(float v, int o, int lane) { return bperm(lane ^ o, v); }
__device__ __forceinline__ float wave_sum(float v, int lane) {
#pragma unroll
    for (int o = 1; o < 64; o <<= 1) v += shx(v, o, lane);
    return v;
}
__device__ __forceinline__ void unpack8(const u32x4 w, float* f) { f[0] = bf_lo(w.x); f[1] = bf_hi(w.x); f[2] = bf_lo(w.y); f[3] = bf_hi(w.y); f[4] = bf_lo(w.z); f[5] = bf_hi(w.z); f[6] = bf_lo(w.w); f[7] = bf_hi(w.w); }
__device__ __forceinline__ u32x4 pack8(const float* f) { u32x4 w; w.x = cvtpk(f[0], f[1]); w.y = cvtpk(f[2], f[3]); w.z = cvtpk(f[4], f[5]); w.w = cvtpk(f[6], f[7]); return w; }

namespace pg8 {
constexpr int BM = 256, BK = 64, HALF = 128, HTB = HALF * BK * 2, STAGE_BYTES = 8 * HTB, NXCD = 8, WGM = 4;
__host__ __device__ __forceinline__ int lds_byte(int r, int c) { const int st = (r >> 4) * 2 + (c >> 5), rr = r & 15, cc = c & 31, ob = rr * 64 + cc * 2; return st * 1024 + (ob ^ (((ob >> 9) & 1) << 5)); }
__host__ __device__ __forceinline__ void stage_rc(int b, int& R, int& C) { const int st = b / 1024, sb = b % 1024, swz = sb ^ (((sb >> 9) & 1) << 5); R = (st >> 1) * 16 + swz / 64; C = (st & 1) * 32 + (swz % 64) / 2; }
__host__ __device__ __forceinline__ int perm32(int rho) { const int n = rho >> 4, i = rho & 15; return 8 * (i >> 2) + 4 * n + (i & 3); }
struct Unit { int pm, pn; };
struct Gemm { const bf16_t* A; const bf16_t* Bt; int M, N, K, lda, ldb, bgrp, amode; };
struct StaticOrder {
    int nM, nN, nwg, G, c;
    __device__ void init(int M, int N, int G_, int c_) { nM = M / BM; nN = N / BM; nwg = nM * nN; G = G_; c = c_; }
    __device__ bool next(int i, Unit& u) const {
        const long L = (long)i * G + c; if (L >= nwg) return false;
        int wgid = (int)L; { const int q = nwg / NXCD, r = nwg % NXCD, xcd = wgid % NXCD, off = wgid / NXCD; wgid = (xcd < r ? xcd * (q + 1) : r * (q + 1) + (xcd - r) * q) + off; }
        const int nig = WGM * nN, gid = wgid / nig, fm = gid * WGM, gsz = (nM - fm) < WGM ? (nM - fm) : WGM;
        u.pm = fm + ((wgid % nig) % gsz); u.pn = (wgid % nig) / gsz; return true;
    }
};
template <class Epi>
__device__ __forceinline__ void gemm_phase(LAS unsigned char* lds, const Gemm g, const StaticOrder& S, const Epi& E, const int wv) {
    const int tid = tid_of(wv);
    const int wid = __builtin_amdgcn_readfirstlane(tid >> 6), lane = tid & 63, wr = wid >> 2, wc = wid & 3, fr = lane & 15, fq = lane >> 4;
    const int nt = g.K / BK;
    unsigned voffA[2], voffB[2];
#pragma unroll
    for (int i = 0; i < 2; ++i) { int R, C; stage_rc(tid * 16 + i * 8192, R, C); const int Rb = (R & ~31) + perm32(R & 31);
        voffA[i] = g.amode ? (unsigned)((C >> 4) * (g.M * 16) + R * 16 + (C & 15)) * 2u : (unsigned)(R * g.lda + C) * 2u; voffB[i] = (unsigned)(Rb * g.ldb + C) * 2u; }
    const size_t kstep = (size_t)(BK * 2), kstepA = g.amode ? (size_t)4 * g.M * 16 * 2 : kstep;
    const size_t hsA = (size_t)HALF * g.lda * 2, hsB = (size_t)HALF * g.ldb * 2, tsA = 2 * hsA, tsB = 2 * hsB;
    const unsigned ldsw = (unsigned)wid * 1024u;
    const int aoff = lds_byte(wr * 64 + fr, fq * 8), boff = lds_byte(wc * 32 + fr, fq * 8);
#define PG8_SA(b, h) (((b) * 2 + (h)) * HTB)
#define PG8_SB(b, h) ((4 + (b) * 2 + (h)) * HTB)
#define PG8_STAGE(bufoff, gbase, voff) do { _Pragma("unroll") for (int _i = 0; _i < 2; ++_i) \
        __builtin_amdgcn_global_load_lds((const unsigned*)((const char*)(gbase) + (voff)[_i]), (LAS unsigned*)(lds + (bufoff) + ldsw + _i * 8192), 16, 0, 0); } while (0)
#define PG8_LDA(dst, b, h) do { _Pragma("unroll") for (int m = 0; m < 4; ++m) _Pragma("unroll") for (int k = 0; k < 2; ++k) dst[m][k] = *(const LAS bf16x8*)(lds + PG8_SA(b, h) + aoff + m * 2048 + k * 1024); } while (0)
#define PG8_LDB(dst, b, h) do { _Pragma("unroll") for (int n = 0; n < 2; ++n) _Pragma("unroll") for (int k = 0; k < 2; ++k) dst[n][k] = *(const LAS bf16x8*)(lds + PG8_SB(b, h) + boff + n * 2048 + k * 1024); } while (0)
#define PG8_MMA(ai, bj, At, Bt) do { __builtin_amdgcn_s_setprio(1); _Pragma("unroll") for (int m = 0; m < 4; ++m) _Pragma("unroll") for (int n = 0; n < 2; ++n) _Pragma("unroll") for (int k = 0; k < 2; ++k) \
        acc[ai][bj][m][n] = __builtin_amdgcn_mfma_f32_16x16x32_bf16(Bt[n][k], At[m][k], acc[ai][bj][m][n], 0, 0, 0); __builtin_amdgcn_s_setprio(0); } while (0)
#define PG8_WAIT_V(n) asm volatile("s_waitcnt vmcnt(" #n ")" ::: "memory")
#define PG8_WAIT_L(n) asm volatile("s_waitcnt lgkmcnt(" #n ")" ::: "memory")
#define PG8_BAR __builtin_amdgcn_s_barrier()
#define PG8_SCHED __builtin_amdgcn_sched_barrier(0)
#define PG8_BIDX(u) (g.bgrp >= 0 ? ((u).pm >> g.bgrp) : (u).pn)
    Unit cur, nxt; int ui = 0;
    if (!S.next(0, cur)) return;
    f32x4 acc[2][2][4][2];
#pragma unroll
    for (int a = 0; a < 2; ++a)
#pragma unroll
        for (int b = 0; b < 2; ++b)
#pragma unroll
            for (int m = 0; m < 4; ++m)
#pragma unroll
                for (int n = 0; n < 2; ++n) acc[a][b][m][n] = (f32x4){0.f, 0.f, 0.f, 0.f};
    bf16x8 At[4][2], B0[2][2], B1[2][2];
    const char* cA = (const char*)g.A + (size_t)cur.pm * tsA; const char* cB = (const char*)g.Bt + (size_t)PG8_BIDX(cur) * tsB;
    PG8_STAGE(PG8_SB(0, 0), cB, voffB); PG8_STAGE(PG8_SB(0, 1), cB + hsB, voffB); PG8_STAGE(PG8_SA(0, 0), cA, voffA); PG8_STAGE(PG8_SA(0, 1), cA + hsA, voffA);
    if (wr == 1) PG8_BAR;
    PG8_WAIT_V(2); PG8_BAR;
    PG8_STAGE(PG8_SB(1, 0), cB + kstep, voffB); PG8_STAGE(PG8_SA(1, 0), cA + kstepA, voffA); PG8_STAGE(PG8_SB(1, 1), cB + hsB + kstep, voffB);
    PG8_WAIT_V(6); PG8_BAR;
    for (;;) {
        const bool has_next = S.next(ui + 1, nxt);
        const char* nA = has_next ? (const char*)g.A + (size_t)nxt.pm * tsA : cA; const char* nB = has_next ? (const char*)g.Bt + (size_t)PG8_BIDX(nxt) * tsB : cB;
#pragma unroll 1
        for (int t = 0; t < nt; t += 2) {
            const bool last = (t == nt - 2);
            const char* a1 = cA + (size_t)(t + 1) * kstepA;
            const char* a2 = last ? nA : cA + (size_t)(t + 2) * kstepA; const char* b2 = last ? nB : cB + (size_t)(t + 2) * kstep;
            const char* a3 = a2 + kstepA; const char* b3 = b2 + kstep;
            asm volatile("" : "+s"(a1), "+s"(a2), "+s"(b2), "+s"(a3), "+s"(b3));
            PG8_LDB(B0, 0, 0); PG8_LDB(B1, 0, 1); PG8_SCHED; PG8_LDA(At, 0, 0); PG8_STAGE(PG8_SA(1, 1), a1 + hsA, voffA);
            PG8_WAIT_V(8); PG8_WAIT_L(0); PG8_BAR; PG8_MMA(0, 0, At, B0); PG8_MMA(0, 1, At, B1); PG8_BAR; PG8_SCHED;
            PG8_LDA(At, 0, 1); PG8_STAGE(PG8_SB(0, 0), b2, voffB); PG8_STAGE(PG8_SB(0, 1), b2 + hsB, voffB); PG8_STAGE(PG8_SA(0, 0), a2, voffA);
            PG8_WAIT_V(8); PG8_WAIT_L(0); PG8_BAR; PG8_MMA(1, 0, At, B0); PG8_MMA(1, 1, At, B1); PG8_BAR; PG8_SCHED;
            PG8_LDB(B0, 1, 0); PG8_LDB(B1, 1, 1); PG8_SCHED; PG8_LDA(At, 1, 0); PG8_STAGE(PG8_SA(0, 1), a2 + hsA, voffA);
            PG8_WAIT_V(8); PG8_WAIT_L(0); PG8_BAR; PG8_MMA(0, 0, At, B0); PG8_MMA(0, 1, At, B1); PG8_BAR; PG8_SCHED;
            PG8_LDA(At, 1, 1); PG8_STAGE(PG8_SB(1, 0), b3, voffB); PG8_STAGE(PG8_SB(1, 1), b3 + hsB, voffB); PG8_STAGE(PG8_SA(1, 0), a3, voffA);
            PG8_WAIT_V(8); PG8_WAIT_L(0); PG8_BAR; PG8_MMA(1, 0, At, B0); PG8_MMA(1, 1, At, B1); PG8_BAR; PG8_SCHED;
        }
        if (wr == 0) PG8_BAR;
        E(acc, cur, wr, wc, fr, fq);
        if (!has_next) break;
#pragma unroll
        for (int a = 0; a < 2; ++a)
#pragma unroll
            for (int b = 0; b < 2; ++b)
#pragma unroll
                for (int m = 0; m < 4; ++m)
#pragma unroll
                    for (int n = 0; n < 2; ++n) acc[a][b][m][n] = (f32x4){0.f, 0.f, 0.f, 0.f};
        cur = nxt; cA = nA; cB = nB; ++ui;
        if (wr == 1) PG8_BAR;
    }
    PG8_WAIT_V(0);
    PG8_BAR;
#undef PG8_SA
#undef PG8_SB
#undef PG8_STAGE
#undef PG8_LDA
#undef PG8_LDB
#undef PG8_MMA
#undef PG8_WAIT_V
#undef PG8_WAIT_L
#undef PG8_BAR
#undef PG8_SCHED
#undef PG8_BIDX
}
}
using pg8::Unit;
typedef const f32x4 (&AccRef)[2][2][4][2];

__device__ __forceinline__ float row_rs(const float* part, int r, int nslots) {
    const float* p = part + (size_t)r * 32; float s;
    if (nslots == 1) s = p[0];
    else { f32x4 a = ((const f32x4*)p)[0];
        for (int k = 1; k < nslots / 4; ++k) a += ((const f32x4*)p)[k];
        s = (a.x + a.y) + (a.z + a.w); }
    return rsqrtf(s * (1.f / DM) + EPS);
}
template <int ACT, int NBJ> struct EpiBf16 {
    bf16_t* O; int ldc; const float* rowss; int nslots;
    __device__ __forceinline__ void operator()(AccRef acc, const Unit& u, int wr, int wc, int fr, int fq) const {
        const int row0 = u.pm * 256 + wr * 64 + fr, col0 = u.pn * 256 + wc * 32 + 8 * fq;
#pragma unroll
        for (int ai = 0; ai < 2; ++ai)
#pragma unroll
            for (int m = 0; m < 4; ++m) { bf16_t* rowp = O + (size_t)(row0 + ai * 128 + m * 16) * ldc + col0;
                const float rsc = rowss ? rowss[row0 + ai * 128 + m * 16] : 1.f;
#pragma unroll
                for (int bj = 0; bj < NBJ; ++bj) { f32x4 v0 = acc[ai][bj][m][0] * rsc, v1 = acc[ai][bj][m][1] * rsc;
                    if (ACT == 1) {
#pragma unroll
                        for (int e = 0; e < 4; ++e) { float a = fmaxf(v0[e], 0.f), b = fmaxf(v1[e], 0.f); v0[e] = a * a; v1[e] = b * b; } }
                    u32x4 w; w.x = cvtpk(v0[0], v0[1]); w.y = cvtpk(v0[2], v0[3]); w.z = cvtpk(v1[0], v1[1]); w.w = cvtpk(v1[2], v1[3]);
                    if (ACT == 1) __builtin_nontemporal_store(w, (u32x4*)(rowp + bj * 128)); else *(u32x4*)(rowp + bj * 128) = w; } }
    }
};
struct EpiResid {
    bf16_t* xb; float* rowss; float* outf;
    __device__ __forceinline__ void operator()(AccRef acc, const Unit& u, int wr, int wc, int fr, int fq) const {
        const int row0 = u.pm * 256 + wr * 64 + fr, col0 = u.pn * 256 + wc * 32 + 8 * fq, lane = fq * 16 + fr;
        u32x4 xin[2][4][2];
#pragma unroll
        for (int ai = 0; ai < 2; ++ai)
#pragma unroll
            for (int m = 0; m < 4; ++m)
#pragma unroll
                for (int bj = 0; bj < 2; ++bj) xin[ai][m][bj] = *(const u32x4*)(xb + (size_t)(row0 + ai * 128 + m * 16) * DM + col0 + bj * 128);
#pragma unroll
        for (int ai = 0; ai < 2; ++ai)
#pragma unroll
            for (int m = 0; m < 4; ++m) { const size_t off = (size_t)(row0 + ai * 128 + m * 16) * DM + col0; float ss = 0.f;
#pragma unroll
                for (int bj = 0; bj < 2; ++bj) {
                    float b[8]; unpack8(xin[ai][m][bj], b);
                    const f32x4 a0 = acc[ai][bj][m][0], a1 = acc[ai][bj][m][1];
                    float o[8];
#pragma unroll
                    for (int e = 0; e < 4; ++e) { o[e] = b[e] + a0[e]; o[4 + e] = b[4 + e] + a1[e]; }
                    if (outf) { __builtin_nontemporal_store((f32x4){o[0], o[1], o[2], o[3]}, (f32x4*)(outf + off + bj * 128)); __builtin_nontemporal_store((f32x4){o[4], o[5], o[6], o[7]}, (f32x4*)(outf + off + bj * 128 + 4)); }
                    else { *(u32x4*)(xb + off + bj * 128) = pack8(o);
#pragma unroll
                        for (int e = 0; e < 8; ++e) ss += o[e] * o[e]; } }
                if (!outf) { ss += shx(ss, 16, lane); ss += shx(ss, 32, lane); if (fq == 0) rowss[(size_t)(row0 + ai * 128 + m * 16) * 32 + u.pn * 4 + wc] = ss; } }
    }
};
struct EpiGlu {
    bf16_t* xb; float* rowss;
    __device__ __forceinline__ void operator()(AccRef acc, const Unit& u, int wr, int wc, int fr, int fq) const {
        const int row0 = u.pm * 256 + wr * 64 + fr, col0 = u.pn * 128 + wc * 32 + 8 * fq, lane = fq * 16 + fr;
        u32x4 xin[2][4];
#pragma unroll
        for (int ai = 0; ai < 2; ++ai)
#pragma unroll
            for (int m = 0; m < 4; ++m) xin[ai][m] = *(const u32x4*)(xb + (size_t)(row0 + ai * 128 + m * 16) * DM + col0);
#pragma unroll
        for (int ai = 0; ai < 2; ++ai)
#pragma unroll
            for (int m = 0; m < 4; ++m) { const size_t off = (size_t)(row0 + ai * 128 + m * 16) * DM + col0; float ss = 0.f;
                float b[8], o[8]; unpack8(xin[ai][m], b);
#pragma unroll
                for (int n = 0; n < 2; ++n) { const f32x4 v = acc[ai][0][m][n], gt = acc[ai][1][m][n];
#pragma unroll
                    for (int e = 0; e < 4; ++e) { o[4 * n + e] = b[4 * n + e] + v[e] * __builtin_amdgcn_rcpf(1.f + __builtin_amdgcn_exp2f(-gt[e] * LOG2E)); ss += o[4 * n + e] * o[4 * n + e]; } }
                *(u32x4*)(xb + off) = pack8(o);
                ss += shx(ss, 16, lane); ss += shx(ss, 32, lane); if (fq == 0) rowss[(size_t)(row0 + ai * 128 + m * 16) * 32 + u.pn * 4 + wc] = ss; }
    }
};
struct EpiS5Y {
    bf16_t* G;
    __device__ __forceinline__ void operator()(AccRef acc, const Unit& u, int wr, int wc, int fr, int fq) const {
        const int row0 = u.pm * 256 + wr * 64 + fr;
#pragma unroll
        for (int ai = 0; ai < 2; ++ai)
#pragma unroll
            for (int m = 0; m < 4; ++m) { const int r = row0 + ai * 128 + m * 16; const int grp = r >> 12, rc = r & 4095, b = rc >> 8, c = rc & 255;
#pragma unroll
                for (int bj = 0; bj < 2; ++bj) { const int n0 = bj * 128 + wc * 32 + 8 * fq, l = n0 >> 4, o0 = n0 & 15;
                    float y[8];
#pragma unroll
                    for (int e = 0; e < 4; ++e) { y[e] = acc[ai][bj][m][0][e]; y[4 + e] = acc[ai][bj][m][1][e]; }
#pragma unroll
                    for (int e = 0; e < 8; ++e) { const float v = y[e], t = 0.7978845608f * (v + 0.044715f * v * v * v); y[e] = v * __builtin_amdgcn_rcpf(1.f + __builtin_amdgcn_exp2f(-2.f * LOG2E * t)); }
                    *(u32x4*)(G + ((size_t)grp * MTOK + (b * SEQ + c * S5L + l)) * 16 + o0) = pack8(y);     asm volatile("" ::: "memory"); } }
    }
};

__device__ __forceinline__ int crow(int r, int hi) { return (r & 3) + 8 * (r >> 2) + 4 * hi; }
typedef short v4i16_t __attribute__((ext_vector_type(4)));
__device__ __forceinline__ v4i16_t vtr(const LAS char* p) { return __builtin_amdgcn_ds_read_tr16_b64_v4i16((LAS v4i16_t*)p); }

__device__ __forceinline__ float swap32_other(float v, int hi) {
    const unsigned u = __builtin_bit_cast(unsigned, v);
    auto rr = __builtin_amdgcn_permlane32_swap(u, u, false, false);
    return __builtin_bit_cast(float, hi ? rr[0] : rr[1]);
}
template <int DK, bool MOBA>
__device__ __forceinline__ void attn_head(const bf16_t* __restrict__ Q, int ldq, const bf16_t* __restrict__ K, int ldk, const bf16_t* __restrict__ V, int ldv,
                                          bf16_t* __restrict__ O, int ldo, const bf16_t* __restrict__ kmean, LAS char* lds, unsigned qmask, const int wv, const bool fast) {
    constexpr int KS = DK * 2 + 16, VS = 192, KCH = DK / 8, NDS = DK / 16;
    constexpr int KBUF = 64 * KS, VBUF = 64 * VS;
    constexpr int VOFF = 2 * KBUF;
    const int tid = tid_of(wv);
    const int lane = tid & 63, wid = __builtin_amdgcn_readfirstlane(tid >> 6), r32 = lane & 31, hi = lane >> 5;
    const int kr0 = tid / KCH, kc0 = tid % KCH, kr1 = (tid + 512) / KCH, kc1 = (tid + 512) % KCH;
    const bool k2 = (DK == 96) && (tid + 512 < 64 * KCH);
    const int vr = tid >> 3, vc = tid & 7;
    const int i16 = lane & 15, cb = (lane >> 4) & 1;
    const int vlane = (4 * hi + (i16 >> 2)) * VS + (16 * cb + 4 * (i16 & 3)) * 2;
    const short one_b = (r32 == 0) ? (short)0x3F80 : (short)0;
    const bf16x8 onesf = (bf16x8){one_b, one_b, one_b, one_b, one_b, one_b, one_b, one_b};
#define AT_LOADK(t_) do { const size_t rb_ = (size_t)(t_) * 64; kg0 = *(const u32x4*)(K + (rb_ + kr0) * ldk + kc0 * 8); if (k2) kg1 = *(const u32x4*)(K + (rb_ + kr1) * ldk + kc1 * 8); } while (0)
#define AT_LOADV(t_) do { const size_t rb_ = (size_t)(t_) * 64; vg = *(const u32x4*)(V + (rb_ + vr) * ldv + vc * 8); } while (0)
#define AT_STK(slot_) do { LAS char* kb_ = lds + (slot_) * KBUF; *(LAS u32x4*)(kb_ + kr0 * KS + kc0 * 16) = kg0; if (k2) *(LAS u32x4*)(kb_ + kr1 * KS + kc1 * 16) = kg1; } while (0)
#define AT_STV(slot_) do { *(LAS u32x4*)(lds + VOFF + (slot_) * VBUF + vr * VS + vc * 16) = vg; } while (0)
#define AT_QK(P0_, P1_, slot_) do { const LAS char* kb_ = lds + (slot_) * KBUF; \
        _Pragma("unroll") for (int ds = 0; ds < NDS; ++ds) { \
            const bf16x8 ka_ = *(const LAS bf16x8*)(kb_ + r32 * KS + (ds * 16 + hi * 8) * 2); \
            const bf16x8 kc_ = *(const LAS bf16x8*)(kb_ + (32 + r32) * KS + (ds * 16 + hi * 8) * 2); \
            if (ds == 0) { P0_ = __builtin_amdgcn_mfma_f32_32x32x16_bf16(ka_, qf[0], MOBA ? cbias : zero16, 0, 0, 0); P1_ = __builtin_amdgcn_mfma_f32_32x32x16_bf16(kc_, qf[0], MOBA ? cbias : zero16, 0, 0, 0); } \
            else { P0_ = __builtin_amdgcn_mfma_f32_32x32x16_bf16(ka_, qf[ds], P0_, 0, 0, 0); P1_ = __builtin_amdgcn_mfma_f32_32x32x16_bf16(kc_, qf[ds], P1_, 0, 0, 0); } } } while (0)
#define AT_CBIAS(tt_) do { if (MOBA) { const float b_ = ((tt_) < 4 * qb && !((sel >> ((tt_) >> 2)) & 1u)) ? -INFINITY : 0.f; \
        _Pragma("unroll") for (int r = 0; r < 16; ++r) cbias[r] = b_; } } while (0)
    const f32x16 zero16 = (f32x16){0.f, 0.f, 0.f, 0.f, 0.f, 0.f, 0.f, 0.f, 0.f, 0.f, 0.f, 0.f, 0.f, 0.f, 0.f, 0.f};
    if (wid < 4) __builtin_amdgcn_s_setprio(2);
    for (int qb = 15; qb >= 0; --qb) {
        if (!((qmask >> qb) & 1u)) continue;
        const int qrow = qb * 256 + wid * 32 + r32;
        bf16x8 qf[NDS];
#pragma unroll
        for (int ds = 0; ds < NDS; ++ds) qf[ds] = *(const bf16x8*)(Q + (size_t)qrow * ldq + ds * 16 + hi * 8);
        u32x4 kg0, kg1 = (u32x4){0, 0, 0, 0}, vg, kh0, kh1 = (u32x4){0, 0, 0, 0};
        AT_LOADK(0); AT_LOADV(0);
        kh0 = *(const u32x4*)(K + (size_t)(64 + kr0) * ldk + kc0 * 8); if (k2) kh1 = *(const u32x4*)(K + (size_t)(64 + kr1) * ldk + kc1 * 8);
        unsigned sel = 0;
        if (MOBA) {
            if (qb > 0) {
                f32x16 ga = zero16;
#pragma unroll
                for (int ds = 0; ds < 4; ++ds) { const bf16x8 a = *(const bf16x8*)(kmean + (r32 & 15) * 64 + ds * 16 + hi * 8); ga = __builtin_amdgcn_mfma_f32_32x32x16_bf16(a, qf[ds], ga, 0, 0, 0); }
                float gv[16];
#pragma unroll
                for (int r = 0; r < 8; ++r) { const float mine = ga[r], other = swap32_other(mine, hi); const int blk = (r & 3) + 8 * (r >> 2);
                    gv[blk] = hi ? other : mine; gv[blk + 4] = hi ? mine : other; }
#pragma unroll
                for (int j = 0; j < 16; ++j) if (j >= qb) gv[j] = -INFINITY;
#pragma unroll
                for (int it = 0; it < 3; ++it) { float best = -INFINITY; int bi = 0;
#pragma unroll
                    for (int j = 0; j < 16; ++j) if (gv[j] > best) { best = gv[j]; bi = j; }
                    if (best > -INFINITY) { sel |= 1u << bi;
#pragma unroll
                        for (int j = 0; j < 16; ++j) if (j == bi) gv[j] = -INFINITY; } }
            }
        }
        float mref = 0.f; f32x16 o0 = zero16, o1 = zero16, o2 = zero16, cbias = zero16;
        const int nt = 4 * (qb + 1);
        AT_STK(0); AT_STV(0);
        { LAS char* kb_ = lds + KBUF; *(LAS u32x4*)(kb_ + kr0 * KS + kc0 * 16) = kh0; if (k2) *(LAS u32x4*)(kb_ + kr1 * KS + kc1 * 16) = kh1; }
        __syncthreads();
        f32x16 pa0, pa1, pb0, pb1;
        AT_CBIAS(0);
        AT_QK(pa0, pa1, 0);
#define AT_STEP(HASNEXT, FAST, C0, C1, N0, N1) do { \
            const LAS char* vb = lds + VOFF + (t & 1) * VBUF; \
            if (t + 2 < nt) AT_LOADK(t + 2); \
            if (t + 1 < nt) AT_LOADV(t + 1); \
            if (!(FAST)) { if (__builtin_expect(__ballot(mref != 0.f) != 0ull, 0)) { _Pragma("unroll") for (int r = 0; r < 16; ++r) { C0[r] -= mref; C1[r] -= mref; } } } \
            if (t >= 4 * qb) { const int qrel = 32 * wid + r32, tl = t - 4 * qb; \
                _Pragma("unroll") for (int r = 0; r < 16; ++r) { const int key = 64 * tl + crow(r, hi); if (key > qrel) C0[r] = -INFINITY; if (key + 32 > qrel) C1[r] = -INFINITY; } } \
            if (!(FAST)) { \
                float ma = __builtin_fmaxf(__builtin_fmaxf(C0[0], C0[1]), C1[0]), mb = __builtin_fmaxf(__builtin_fmaxf(C0[2], C0[3]), C1[1]); \
                ma = __builtin_fmaxf(__builtin_fmaxf(ma, C1[2]), C1[3]); \
                _Pragma("unroll") for (int r = 4; r < 16; r += 4) { ma = __builtin_fmaxf(__builtin_fmaxf(ma, C0[r]), C0[r + 1]); mb = __builtin_fmaxf(__builtin_fmaxf(mb, C0[r + 2]), C0[r + 3]); \
                    ma = __builtin_fmaxf(__builtin_fmaxf(ma, C1[r]), C1[r + 1]); mb = __builtin_fmaxf(__builtin_fmaxf(mb, C1[r + 2]), C1[r + 3]); } \
                float mx = __builtin_fmaxf(ma, mb); mx = __builtin_fmaxf(mx, swap32_other(mx, hi)); \
                if (__builtin_expect(__ballot(mx > 20.0f) != 0ull, 0)) { \
                    const float dl = __builtin_fmaxf(mx, 0.f); mref += dl; \
                    _Pragma("unroll") for (int r = 0; r < 16; ++r) { C0[r] -= dl; C1[r] -= dl; } \
                    const float alpha = __builtin_amdgcn_exp2f(-dl); \
                    _Pragma("unroll") for (int r = 0; r < 16; ++r) { o0[r] *= alpha; o1[r] *= alpha; o2[r] *= alpha; } \
                } } \
            if (HASNEXT) { if (((t + 1) & 3) == 0) AT_CBIAS(t + 1); AT_QK(N0, N1, (t + 1) & 1); } \
            _Pragma("unroll") for (int r = 0; r < 16; ++r) { C0[r] = __builtin_amdgcn_exp2f(C0[r]); C1[r] = __builtin_amdgcn_exp2f(C1[r]); } \
            _Pragma("unroll") for (int s = 0; s < 4; ++s) { \
                u32x4 pw; \
                if (s == 0) pw = (u32x4){cvtpk(C0[0], C0[1]), cvtpk(C0[2], C0[3]), cvtpk(C0[4], C0[5]), cvtpk(C0[6], C0[7])}; \
                else if (s == 1) pw = (u32x4){cvtpk(C0[8], C0[9]), cvtpk(C0[10], C0[11]), cvtpk(C0[12], C0[13]), cvtpk(C0[14], C0[15])}; \
                else if (s == 2) pw = (u32x4){cvtpk(C1[0], C1[1]), cvtpk(C1[2], C1[3]), cvtpk(C1[4], C1[5]), cvtpk(C1[6], C1[7])}; \
                else pw = (u32x4){cvtpk(C1[8], C1[9]), cvtpk(C1[10], C1[11]), cvtpk(C1[12], C1[13]), cvtpk(C1[14], C1[15])}; \
                const bf16x8 pa = __builtin_bit_cast(bf16x8, pw); \
                const LAS char* vp = vb + vlane + (16 * s) * VS; \
                const v4i16_t a0 = vtr(vp), a1 = vtr(vp + 8 * VS), b0 = vtr(vp + 64), b1 = vtr(vp + 8 * VS + 64); \
                const bf16x8 va = (bf16x8){a0[0], a0[1], a0[2], a0[3], a1[0], a1[1], a1[2], a1[3]}; \
                const bf16x8 vb8 = (bf16x8){b0[0], b0[1], b0[2], b0[3], b1[0], b1[1], b1[2], b1[3]}; \
                o0 = __builtin_amdgcn_mfma_f32_32x32x16_bf16(va, pa, o0, 0, 0, 0); \
                o1 = __builtin_amdgcn_mfma_f32_32x32x16_bf16(vb8, pa, o1, 0, 0, 0); \
                o2 = __builtin_amdgcn_mfma_f32_32x32x16_bf16(onesf, pa, o2, 0, 0, 0); \
            } \
            if (t + 2 < nt) AT_STK(t & 1); \
            if (t + 1 < nt) AT_STV((t + 1) & 1); \
            asm volatile("s_waitcnt lgkmcnt(0)" ::: "memory"); __builtin_amdgcn_s_barrier(); asm volatile("" ::: "memory");     \
        } while (0)
        int t = 0;
        if (fast) {
            for (; t < nt - 2; ) { AT_STEP(true, true, pa0, pa1, pb0, pb1); ++t; AT_STEP(true, true, pb0, pb1, pa0, pa1); ++t; }
            AT_STEP(true, true, pa0, pa1, pb0, pb1); ++t; AT_STEP(false, true, pb0, pb1, pa0, pa1);
        } else {
            for (; t < nt - 2; ) { AT_STEP(true, false, pa0, pa1, pb0, pb1); ++t; AT_STEP(true, false, pb0, pb1, pa0, pa1); ++t; }
            AT_STEP(true, false, pa0, pa1, pb0, pb1); ++t; AT_STEP(false, false, pb0, pb1, pa0, pa1);
        }
#undef AT_STEP
        const float lv = o2[0], lo_ = swap32_other(lv, hi), ltot = hi ? lo_ : lv, inv = 1.f / ltot;
        bf16_t* orow = O + (size_t)qrow * ldo + 4 * hi;
#pragma unroll
        for (int g4 = 0; g4 < 4; ++g4) {
            u32x2 w0, w1;
            w0.x = cvtpk(o0[4 * g4] * inv, o0[4 * g4 + 1] * inv); w0.y = cvtpk(o0[4 * g4 + 2] * inv, o0[4 * g4 + 3] * inv);
            w1.x = cvtpk(o1[4 * g4] * inv, o1[4 * g4 + 1] * inv); w1.y = cvtpk(o1[4 * g4 + 2] * inv, o1[4 * g4 + 3] * inv);
            *(u32x2*)(orow + 8 * g4) = w0; *(u32x2*)(orow + 32 + 8 * g4) = w1;
        }
    }
    __builtin_amdgcn_s_setprio(0);
#undef AT_LOADK
#undef AT_LOADV
#undef AT_STK
#undef AT_STV
#undef AT_QK
#undef AT_CBIAS
}

#define XB_TMO      128
#define XB_XCNT(j)  (256  + 64 * (j))
#define XB_XSUB(j)  (1280 + 64 * (j))
#define XB_XGEN(j)  (2304 + 64 * (j))
#define XB_TOP      3328
#define XB_TOPGEN   3392
#define XCD_BAR_WORDS 3456
#define XB_SPIN_CAP (1u << 18)
__device__ __forceinline__ unsigned xb_ld(unsigned* p)              { return __hip_atomic_load(p, __ATOMIC_RELAXED, __HIP_MEMORY_SCOPE_AGENT); }
__device__ __forceinline__ unsigned xb_add(unsigned* p, unsigned v) { return __hip_atomic_fetch_add(p, v, __ATOMIC_RELAXED, __HIP_MEMORY_SCOPE_AGENT); }
__device__ __forceinline__ unsigned xb_xcc_id() { return (unsigned)__builtin_amdgcn_s_getreg((3 << 11) | 20) & 0xFu; }
#define XB_SPIN(cond, bar) do { unsigned _sp = 0; while (cond) { __builtin_amdgcn_s_sleep(1); \
    if ((++_sp & 255u) == 0u) { if (xb_ld(&(bar)[XB_TMO])) break; if (_sp > XB_SPIN_CAP) { atomicAdd(&(bar)[XB_TMO], 1u); break; } } } } while (0)
struct XcdBarrier { unsigned* bar; unsigned x; volatile LAS unsigned* st; };
__device__ __forceinline__ XcdBarrier xcd_barrier_post(unsigned* bar, volatile LAS unsigned* st) {
    XcdBarrier b; b.bar = bar; b.x = xb_xcc_id(); b.st = st;
    if (threadIdx.x == 0) (void)xb_add(&bar[XB_XCNT(b.x)], 1u);
    return b;
}
__device__ __forceinline__ void xcd_barrier_complete(unsigned* bar, unsigned x, unsigned& nloc, unsigned& nx) {
    const unsigned G = gridDim.x * gridDim.y * gridDim.z;
    unsigned sum, cnt, mine, sp = 0u;
    for (;;) {
        sum = 0u; cnt = 0u; mine = 0u;
#pragma unroll
        for (unsigned j = 0; j < 16; ++j) { const unsigned c = xb_ld(&bar[XB_XCNT(j)]); sum += c; cnt += (c > 0u) ? 1u : 0u; mine = (j == x) ? c : mine; }
        if (sum == G) break;
        __builtin_amdgcn_s_sleep(1);
        if ((++sp & 255u) == 0u) { if (xb_ld(&bar[XB_TMO])) break; if (sp > XB_SPIN_CAP) { atomicAdd(&bar[XB_TMO], 1u); break; } }
    }
    nloc = mine > 0u ? mine : 1u; nx = cnt > 0u ? cnt : 1u;
}
__device__ __forceinline__ void xcd_barrier(const XcdBarrier& b, const int wv) {
    asm volatile("s_waitcnt vmcnt(0)" ::: "memory");
    __syncthreads();
    const int t0 = tid_of(wv);
    if (t0 == 0) {
        unsigned* bar = b.bar;
        __builtin_amdgcn_s_waitcnt(0);
        unsigned nloc = b.st[0], nx = b.st[1];
        if (nloc == 0u) { xcd_barrier_complete(bar, b.x, nloc, nx); b.st[0] = nloc; b.st[1] = nx; }
        const unsigned old = xb_add(&bar[XB_XSUB(b.x)], 1u);
        const unsigned gen = old / nloc;
        if (old + 1u == (gen + 1u) * nloc) {
            __builtin_amdgcn_fence(__ATOMIC_RELEASE, "agent");
            asm volatile("s_waitcnt vmcnt(0)" ::: "memory");
            const unsigned og = xb_add(&bar[XB_TOP], 1u);
            const unsigned tg = og / nx;
            if (og + 1u == (tg + 1u) * nx) xb_add(&bar[XB_TOPGEN], 1u);
            else XB_SPIN(xb_ld(&bar[XB_TOPGEN]) == tg, bar);
            __builtin_amdgcn_fence(__ATOMIC_ACQUIRE, "agent");
            xb_add(&bar[XB_XGEN(b.x)], 1u);
            asm volatile("s_waitcnt vmcnt(0)" ::: "memory");
        } else {
            XB_SPIN(xb_ld(&bar[XB_XGEN(b.x)]) == gen, bar);
            __builtin_amdgcn_fence(__ATOMIC_ACQUIRE, "agent");
            asm volatile("s_waitcnt vmcnt(0)" ::: "memory");
        }
    }
    __syncthreads();
}

__device__ __forceinline__ int obid() { int b = blockIdx.x; asm volatile("" : "+s"(b)); return b; }
struct Args { const float* in[24]; float* out; unsigned char* ws; };
constexpr int ARGTBL_OFF = 139264;
struct Tbl {
    const LAS unsigned* t;
    __device__ __forceinline__ unsigned long long q(int i) const { const LAS unsigned* p = t; asm volatile("" : "+v"(p)); const unsigned lo = __builtin_amdgcn_readfirstlane(p[2 * i]), hi = __builtin_amdgcn_readfirstlane(p[2 * i + 1]); return ((unsigned long long)hi << 32) | lo; }
    __device__ __forceinline__ const float* in(int i) const { return (const float*)(const __attribute__((address_space(1))) float*)q(i); }
    __device__ __forceinline__ float* out() const { return (float*)(__attribute__((address_space(1))) float*)q(24); }
    __device__ __forceinline__ unsigned char* ws() const { return (unsigned char*)(__attribute__((address_space(1))) unsigned char*)q(25); }
};

__device__ __forceinline__ void tr_item(const float* __restrict__ W, int N, bf16_t* __restrict__ WT, int ldt, int drow0, LAS float* scr, int k0, int n0, int lane, const float* __restrict__ gk) {
#pragma unroll
    for (int i = 0; i < 32; ++i) { const int kk = 2 * i + (lane >> 5); scr[kk * 33 + (lane & 31)] = W[(size_t)(k0 + kk) * N + n0 + (lane & 31)] * (gk ? gk[k0 + kk] : 1.f); }
    asm volatile("s_waitcnt lgkmcnt(0)" ::: "memory");
    const int c = lane & 7;
#pragma unroll
    for (int j = 0; j < 4; ++j) { const int n = (lane >> 3) + 8 * j; const LAS float* s = scr + (8 * c) * 33 + n;
        u32x4 o; o.x = pk2(s[0], s[33]); o.y = pk2(s[2 * 33], s[3 * 33]); o.z = pk2(s[4 * 33], s[5 * 33]); o.w = pk2(s[6 * 33], s[7 * 33]);
        *(u32x4*)(WT + (size_t)(drow0 + n) * ldt + k0 + 8 * c) = o; }
    asm volatile("s_waitcnt lgkmcnt(0)" ::: "memory");
}
__device__ __forceinline__ void tr_matrix(const float* W, int K, int N, bf16_t* WT, int ldt, int mode, LAS float* scr, int gw, int ngw, int lane, const float* gk = nullptr) {
    const int nblk = N / 32, nitems = (K / 64) * nblk;
    for (int it = gw; it < nitems; it += ngw) { const int kb = it / nblk, nb = it % nblk, n0 = 32 * nb;
        int drow0 = n0;
        if (mode == 1) { const int nn = n0 & 1023; drow0 = 256 * (nn >> 7) + (nn & 127) + ((n0 >> 10) ? 128 : 0); }
        tr_item(W, N, WT, ldt, drow0, scr, 64 * kb, n0, lane, gk); }
}

__device__ __forceinline__ void s5_prep(const Tbl a, int layer_i, int grp, LAS char* lds, const int part) {
    LAS f32x2* apow = (LAS f32x2*)lds;
    LAS f32x2* bb = apow + 17 * 64;
    LAS f32x2* cc = bb + 64 * 16;
    LAS float* ker = (LAS float*)(cc + 16 * 64);
    const int tid = threadIdx.x;
    const float* lam_re = a.in(13) + (size_t)(layer_i * 64 + grp) * 64; const float* lam_im = a.in(14) + (size_t)(layer_i * 64 + grp) * 64;
    const float dt = expf(a.in(15)[layer_i * 64 + grp]);
    const float* b_re = a.in(16) + (size_t)(layer_i * 64 + grp) * 1024; const float* b_im = a.in(17) + (size_t)(layer_i * 64 + grp) * 1024;
    const float* c_re = a.in(18) + (size_t)(layer_i * 64 + grp) * 1024; const float* c_im = a.in(19) + (size_t)(layer_i * 64 + grp) * 1024;
    const float* dsk = a.in(20) + (size_t)layer_i * DM + grp * 16;
    for (int e = tid; e < 17 * 64; e += 512) { const int m = e >> 6, p = e & 63; const float lr = lam_re[p], li = lam_im[p];
        const float mag = expf(lr * dt * (float)m); float rev = (li * dt * (float)m) * 0.15915494309189535f; rev -= rintf(rev);
        apow[e] = (f32x2){mag * __builtin_amdgcn_cosf(rev), mag * __builtin_amdgcn_sinf(rev)}; }
    __syncthreads();
    for (int e = tid; e < 1024; e += 512) { const int p = e >> 4; const float lr = lam_re[p], li = lam_im[p];
        const f32x2 a1 = apow[64 + p]; const float nr = a1.x - 1.f, ni = a1.y, den = 1.f / (lr * lr + li * li);
        const float cr = (nr * lr + ni * li) * den, ci = (ni * lr - nr * li) * den;
        const float br = b_re[e], bi = b_im[e]; bb[e] = (f32x2){cr * br - ci * bi, cr * bi + ci * br}; }
    if (part == 0 && tid < 64) { float* A16 = (float*)(a.ws() + WS_A16) + (size_t)((layer_i * 64 + grp) * 64 + tid) * 2; A16[0] = apow[16 * 64 + tid].x; A16[1] = apow[16 * 64 + tid].y; }
    if (part == 1) for (int e = tid; e < 1024; e += 512) cc[e] = (f32x2){c_re[e], c_im[e]};
    __syncthreads();
    if (part == 1) {
    for (int e = tid; e < 4096; e += 512) { const int m = e >> 8, o = (e >> 4) & 15, i = e & 15; float s = 0.f;
        for (int p = 0; p < 64; ++p) { const f32x2 c = cc[o * 64 + p], ap = apow[m * 64 + p], b = bb[p * 16 + i];
            const float tr = c.x * ap.x - c.y * ap.y, ti = c.x * ap.y + c.y * ap.x; s += tr * b.x - ti * b.y; }
        if (m == 0 && o == i) s += dsk[o];
        ker[e] = s; }
    __syncthreads();
    bf16_t* BtB = (bf16_t*)(a.ws() + WS_S5B) + (size_t)(layer_i * 64 + grp) * 256 * S5K;
    for (int ch = tid; ch < 256 * 48; ch += 512) { const int n = ch / 48, kc = ch % 48, l = n >> 4, o = n & 15, k0 = kc * 8; float v[8];
        if (k0 < 256) { const int j = k0 >> 4, i0 = k0 & 15;
#pragma unroll
            for (int e = 0; e < 8; ++e) v[e] = (l >= j) ? ker[((l - j) * 16 + o) * 16 + i0 + e] : 0.f; }
        else {
#pragma unroll
            for (int e = 0; e < 8; ++e) { const int kk = k0 - 256 + e, p = kk >> 1; const f32x2 c = cc[o * 64 + p], ap = apow[(l + 1) * 64 + p];
                v[e] = (kk & 1) ? -(c.x * ap.y + c.y * ap.x) : (c.x * ap.x - c.y * ap.y); } }
        u32x4 w; w.x = pk2(v[0], v[1]); w.y = pk2(v[2], v[3]); w.z = pk2(v[4], v[5]); w.w = pk2(v[6], v[7]);
        *(u32x4*)(BtB + (size_t)n * S5K + k0) = w; }
    } else {
    bf16_t* BtA = (bf16_t*)(a.ws() + WS_S5A) + (size_t)(layer_i * 64 + grp) * 256 * 256;
    for (int ch = tid; ch < 256 * 32; ch += 512) { const int n = ch >> 5, kc = ch & 31, k0 = kc * 8, j = k0 >> 4, i0 = k0 & 15; float v[8];
        if (n < 128) { const int p = n >> 1; const f32x2 ap = apow[(15 - j) * 64 + p];
#pragma unroll
            for (int e = 0; e < 8; ++e) { const f32x2 b = bb[p * 16 + i0 + e]; v[e] = (n & 1) ? (ap.x * b.y + ap.y * b.x) : (ap.x * b.x - ap.y * b.y); } }
        else {
#pragma unroll
            for (int e = 0; e < 8; ++e) v[e] = 0.f; }
        u32x4 w; w.x = pk2(v[0], v[1]); w.y = pk2(v[2], v[3]); w.z = pk2(v[4], v[5]); w.w = pk2(v[6], v[7]);
        *(u32x4*)(BtA + (size_t)n * 256 + k0) = w; }
    }
    __syncthreads();
}

__device__ __forceinline__ void cast_rows(const float* __restrict__ x, bf16_t* __restrict__ xb, float* __restrict__ rowss, int gw, int ngw, int lane) {
    asm volatile("" : "+v"(lane)); asm volatile("" : "+s"(gw));
    for (int m = gw; m < MTOK; m += ngw) {
        const f32x4* xr = (const f32x4*)(x + (size_t)m * DM) + lane; f32x4 v[4]; float s = 0.f;
#pragma unroll
        for (int j = 0; j < 4; ++j) { v[j] = __builtin_nontemporal_load(xr + 64 * j); s += (v[j].x * v[j].x + v[j].y * v[j].y) + (v[j].z * v[j].z + v[j].w * v[j].w); }
        s = wave_sum(s, lane);
        u32x2* o8 = (u32x2*)(xb + (size_t)m * DM) + lane;
#pragma unroll
        for (int j = 0; j < 4; ++j) { u32x2 w; w.x = cvtpk(v[j].x, v[j].y); w.y = cvtpk(v[j].z, v[j].w); o8[64 * j] = w; }
        if (lane == 0) rowss[m] = rsqrtf(s * (1.f / DM) + EPS);
    }
}
__device__ __forceinline__ void norm_rows_s5(const bf16_t* __restrict__ xb, const float* __restrict__ rowss, int nslots, const float* __restrict__ g, bf16_t* __restrict__ A2, int gw, int ngw, int lane) {
    asm volatile("" : "+v"(lane)); asm volatile("" : "+s"(gw));
    float gv[16];
#pragma unroll
    for (int j = 0; j < 4; ++j) { const f32x4 t = ((const f32x4*)g)[4 * lane + j]; gv[4 * j] = t.x; gv[4 * j + 1] = t.y; gv[4 * j + 2] = t.z; gv[4 * j + 3] = t.w; }
    for (int m = gw; m < MTOK; m += ngw) {
        const u32x4* xr = (const u32x4*)(xb + (size_t)m * DM) + 2 * lane; float v[16];
        unpack8(xr[0], v); unpack8(xr[1], v + 8);
        float sp = ((lane & 31) < nslots) ? rowss[(size_t)m * 32 + (lane & 31)] : 0.f;
#pragma unroll
        for (int o = 1; o < 32; o <<= 1) sp += shx(sp, o, lane);
        const float rs = rsqrtf(sp * (1.f / DM) + EPS);
#pragma unroll
        for (int e = 0; e < 16; ++e) v[e] = v[e] * rs * gv[e];
        const int b = m >> 12, t = m & 4095, c = t >> 4, jj = t & 15;
        u32x4* dst = (u32x4*)(A2 + ((size_t)lane * 4096 + b * 256 + c) * S5K + jj * 16);
        dst[0] = pack8(v); dst[1] = pack8(v + 8);
    }
}

__device__ __forceinline__ void p_lat(const Tbl a, int li, bf16_t* PROJ, int gw, int ngw, int lane) {
    asm volatile("" : "+v"(lane)); asm volatile("" : "+s"(gw));
    int seg0, slen, sdim; const float* gp = a.in(4); float extra = 1.f;
    if (lane < 8) { seg0 = 0; slen = 8; sdim = 256; gp = a.in(4) + li * 256 + 32 * lane; }
    else if (lane < 12) { seg0 = 8; slen = 4; sdim = 128; gp = a.in(6) + li * 128 + 32 * (lane - 8); }
    else if (lane == 12) { seg0 = 12; slen = 1; sdim = 32; }
    else if (lane < 29) { seg0 = 13 + ((lane - 13) & ~1); slen = 2; sdim = 64; gp = a.in(10) + li * 64 + 32 * ((lane - 13) & 1); extra = 0.125f * LOG2E; }
    else if (lane < 45) { seg0 = 29 + ((lane - 29) & ~1); slen = 2; sdim = 64; gp = a.in(11) + li * 64 + 32 * ((lane - 29) & 1); }
    else { seg0 = lane; slen = 1; sdim = 32; }
    const f32x2* rope = (const f32x2*)(a.ws() + WS_ROPE);
    u32x4 nx[4];
#pragma unroll
    for (int q = 0; q < 4; ++q) nx[q] = (u32x4){0, 0, 0, 0};
    if (lane < 45 && gw < MTOK) {
#pragma unroll
        for (int q = 0; q < 4; ++q) nx[q] = ((const u32x4*)(PROJ + (size_t)gw * INP + 32 * lane))[q]; }
    for (int m = gw; m < MTOK; m += ngw) {
        u32x4* rp = (u32x4*)(PROJ + (size_t)m * INP + 32 * lane);
        float v[32];
#pragma unroll
        for (int q = 0; q < 4; ++q) unpack8(nx[q], v + 8 * q);
        if (lane < 45 && m + ngw < MTOK) {
#pragma unroll
            for (int q = 0; q < 4; ++q) nx[q] = ((const u32x4*)(PROJ + (size_t)(m + ngw) * INP + 32 * lane))[q]; }
        float ss = 0.f;
#pragma unroll
        for (int e = 0; e < 32; ++e) ss += v[e] * v[e];
        float tot = 0.f;
#pragma unroll
        for (int k = 0; k < 8; ++k) { const float o = bperm((seg0 + k) & 63, ss); if (k < slen) tot += o; }
        if (lane == 12) { const f32x2* rr = rope + (size_t)(m & 4095) * 16;
#pragma unroll
            for (int i = 0; i < 16; ++i) { const f32x2 cs = rr[i]; const float x1 = v[i], x2 = v[16 + i]; v[i] = x1 * cs.x - x2 * cs.y; v[16 + i] = x1 * cs.y + x2 * cs.x; } }
        else if (lane < 45) { const float sc = rsqrtf(tot / (float)sdim + EPS) * extra;
#pragma unroll
            for (int e = 0; e < 32; ++e) v[e] = v[e] * sc * gp[e]; }
        if (lane < 45) {
#pragma unroll
            for (int q = 0; q < 4; ++q) rp[q] = pack8(v + 8 * q); }
    }
}

__device__ __forceinline__ void p_qk(const Tbl a, int li, const bf16_t* PROJ, bf16_t* QR, const bf16_t* KVR, bf16_t* KM, int gw, int ngw, int lane) {
    asm volatile("" : "+v"(lane)); asm volatile("" : "+s"(gw));
    const int h = lane / 6, j = lane - 6 * h; const bool act = lane < 48;
    const int d0 = j < 4 ? 16 * j : 64 + 8 * (j - 4), d1 = j < 4 ? 16 * j + 8 : 80 + 8 * (j - 4);
    const float* gq = a.in(8) + li * 96; const float* gk = a.in(9) + li * 96;
    const f32x2* rope = (const f32x2*)(a.ws() + WS_ROPE);
    const float qscale = 0.10206207261596577f * LOG2E;
    const bf16_t* kb0 = j < 4 ? KVR + 128 * h + d0 : PROJ + C_KR + (d0 - 64); const bf16_t* kb1 = j < 4 ? KVR + 128 * h + d1 : PROJ + C_KR + (d1 - 64);
    const size_t kpitch = j < 4 ? 1024 : INP;
    u32x4 nq0 = (u32x4){0, 0, 0, 0}, nq1 = nq0, nk0 = nq0, nk1 = nq0;
    if (act && gw < MTOK) { nq0 = *(const u32x4*)(QR + (size_t)gw * 768 + 96 * h + d0); nq1 = *(const u32x4*)(QR + (size_t)gw * 768 + 96 * h + d1);
        nk0 = *(const u32x4*)(kb0 + (size_t)gw * kpitch); nk1 = *(const u32x4*)(kb1 + (size_t)gw * kpitch); }
    for (int m = gw; m < MTOK; m += ngw) {
        float q0[8], q1[8], k0[8], k1[8];
        if (act) {
            unpack8(nq0, q0); unpack8(nq1, q1); unpack8(nk0, k0); unpack8(nk1, k1);
            if (m + ngw < MTOK) { const size_t mn = (size_t)(m + ngw);
                nq0 = *(const u32x4*)(QR + mn * 768 + 96 * h + d0); nq1 = *(const u32x4*)(QR + mn * 768 + 96 * h + d1);
                nk0 = *(const u32x4*)(kb0 + mn * kpitch); nk1 = *(const u32x4*)(kb1 + mn * kpitch); }
            if (j >= 4) { const f32x2* rr = rope + (size_t)(m & 4095) * 16 + 8 * (j - 4);
#pragma unroll
                for (int e = 0; e < 8; ++e) { const f32x2 cs = rr[e]; const float x1 = q0[e], x2 = q1[e]; q0[e] = x1 * cs.x - x2 * cs.y; q1[e] = x1 * cs.y + x2 * cs.x; } }
        } else {
#pragma unroll
            for (int e = 0; e < 8; ++e) { q0[e] = q1[e] = k0[e] = k1[e] = 0.f; } }
        float sq = 0.f, sk = 0.f;
#pragma unroll
        for (int e = 0; e < 8; ++e) { sq += q0[e] * q0[e] + q1[e] * q1[e]; sk += k0[e] * k0[e] + k1[e] * k1[e]; }
        float tq = 0.f, tk = 0.f;
#pragma unroll
        for (int k = 0; k < 6; ++k) { const int src = (6 * h + k) & 63; tq += bperm(src, sq); tk += bperm(src, sk); }
        if (act) {
            const float scq = rsqrtf(tq * (1.f / 96.f) + EPS) * qscale, sck = rsqrtf(tk * (1.f / 96.f) + EPS);
#pragma unroll
            for (int e = 0; e < 8; ++e) { q0[e] *= scq * gq[d0 + e]; q1[e] *= scq * gq[d1 + e]; k0[e] *= sck * gk[d0 + e]; k1[e] *= sck * gk[d1 + e]; }
            *(u32x4*)(QR + (size_t)m * 768 + 96 * h + d0) = pack8(q0); *(u32x4*)(QR + (size_t)m * 768 + 96 * h + d1) = pack8(q1);
            *(u32x4*)(KM + (size_t)m * 768 + 96 * h + d0) = pack8(k0); *(u32x4*)(KM + (size_t)m * 768 + 96 * h + d1) = pack8(k1);
        }
    }
}

#define ws (a.ws())
#define out (a.out())
#define XN ((bf16_t*)(ws + WS_XN))
#define OB ((bf16_t*)(ws + WS_OB))
#define ROWSS(i) ((float*)(ws + WS_ROWSS) + (size_t)((i) & 1) * MTOK * 32)
#define RSV(i) ((float*)(ws + WS_RS) + (size_t)((i) & 1) * MTOK)
#define FINALIZE_RS(i, ns) do { const int t_ = tid_of(wave); for (int r_ = obid() * 512 + t_; r_ < MTOK; r_ += G * 512) RSV(i)[r_] = row_rs(ROWSS(i), r_, ns); GSYNC(); } while (0)
#define PROJ ((bf16_t*)(ws + WS_PROJ))
#define QR ((bf16_t*)(ws + WS_QR))
#define KVR ((bf16_t*)(ws + WS_KVR))
#define KM ((bf16_t*)(ws + WS_KM))
#define HID ((bf16_t*)(ws + WS_HID))
#define A2 ((bf16_t*)(ws + WS_A2))
#define XS ((bf16_t*)(ws + WS_XS))
#define GS ((bf16_t*)(ws + WS_GS))
#define KMEAN ((bf16_t*)(ws + WS_KMEAN))

#define GSYNC() do { const XcdBarrier xb_{(unsigned*)ws, xb_xcc_id(), (volatile LAS unsigned*)(lds + ARGTBL_OFF + 256)}; xcd_barrier(xb_, wave); } while (0)
template <int layer>
__device__ __forceinline__ void run_layer(const Tbl a, LAS unsigned char* lds, const int G, const int wave) {
    const int tid = tid_of(wave);
    const int lane = tid & 63;
    const int gw = obid() * 8 + wave, ngw = G * 8;
    pg8::StaticOrder S;
        const int li = layer >> 1;
        if ((layer & 1) == 0) {
            { pg8::Gemm g{XN, (const bf16_t*)(ws + WS_WIN) + (size_t)li * INP * DM, MTOK, INP, DM, DM, DM, -1, 0}; S.init(MTOK, INP, G, obid());
              EpiBf16<0, 2> E{PROJ, INP, RSV(2 * layer), 0}; pg8::gemm_phase(lds, g, S, E, wave); }
            GSYNC();
            p_lat(a, li, PROJ, gw, ngw, lane);
            GSYNC();
            { pg8::Gemm g{PROJ + C_CQ, (const bf16_t*)(ws + WS_WUQ) + (size_t)li * 768 * 256, MTOK, 768, 256, INP, 256, -1, 0}; S.init(MTOK, 768, G, obid());
              EpiBf16<0, 2> E{QR, 768, nullptr, 0}; pg8::gemm_phase(lds, g, S, E, wave); }
            { pg8::Gemm g{PROJ + C_CKV, (const bf16_t*)(ws + WS_WUKV) + (size_t)li * 1024 * 128, MTOK, 1024, 128, INP, 128, -1, 0}; S.init(MTOK, 1024, G, obid());
              EpiBf16<0, 2> E{KVR, 1024, nullptr, 0}; pg8::gemm_phase(lds, g, S, E, wave); }
            GSYNC();
            p_qk(a, li, PROJ, QR, KVR, KM, gw, ngw, lane);
            for (int c = obid(); c < 256; c += G) {
                const int tid = tid_of(wave); const int lane = tid & 63;
                const int b = c >> 4, blk = c & 15; LAS float* red = (LAS float*)lds;
                float s8[8];
#pragma unroll
                for (int e = 0; e < 8; ++e) s8[e] = 0.f;
                for (int r = 0; r < 32; ++r) { float f[8]; unpack8(*(const u32x4*)(PROJ + (size_t)(b * SEQ + blk * 256 + wave * 32 + r) * INP + C_KB + 8 * lane), f);
#pragma unroll
                    for (int e = 0; e < 8; ++e) s8[e] += f[e]; }
#pragma unroll
                for (int e = 0; e < 8; ++e) red[wave * 512 + 8 * lane + e] = s8[e];
                __syncthreads();
                { float s = 0.f;
#pragma unroll
                  for (int w = 0; w < 8; ++w) s += red[w * 512 + tid];
                  KMEAN[((size_t)(b * 8 + (tid >> 6)) * 16 + blk) * 64 + (tid & 63)] = (bf16_t)f2bf(s * (1.f / 256.f)); }
                __syncthreads();
            }
            GSYNC();
            for (int c = obid(); c < 256; c += G) {
                const int xcd = c & 7, j = c >> 3, side = j & 1, h = (j >> 1) & 7, b = 2 * xcd + (j >> 4); const size_t r0 = (size_t)b * SEQ;
                const unsigned m0 = 0x9999u;
                const unsigned qm_mla = side ? (~m0 & 0xffffu) : m0, qm_moba = side ? m0 : (~m0 & 0xffffu);
                attn_head<96, false>(QR + r0 * 768 + 96 * h, 768, KM + r0 * 768 + 96 * h, 768, KVR + r0 * 1024 + 128 * h + 64, 1024, OB + r0 * DM + 64 * h, DM, nullptr, (LAS char*)lds, qm_mla, wave, ((const int*)(ws + WS_FLAGS))[li * 2] != 0);
                attn_head<64, true>(PROJ + r0 * INP + C_QB + 64 * h, INP, PROJ + r0 * INP + C_KB + 64 * h, INP, PROJ + r0 * INP + C_VB + 64 * h, INP, OB + r0 * DM + 512 + 64 * h, DM,
                                    KMEAN + (size_t)(b * 8 + h) * 16 * 64, (LAS char*)lds, qm_moba, wave, ((const int*)(ws + WS_FLAGS))[li * 2 + 1] != 0);
            }
            GSYNC();
            { pg8::Gemm g{OB, (const bf16_t*)(ws + WS_WO) + (size_t)li * DM * DM, MTOK, DM, DM, DM, DM, -1, 0}; S.init(MTOK, DM, G, obid());
              EpiResid E{XN, ROWSS(2 * layer + 1), nullptr}; pg8::gemm_phase(lds, g, S, E, wave); }
            GSYNC();
            FINALIZE_RS(2 * layer + 1, 16);
        } else {
            norm_rows_s5(XN, ROWSS(2 * layer), 16, a.in(1) + layer * DM, A2, gw, ngw, lane);
            GSYNC();
            { pg8::Gemm g{A2, (const bf16_t*)(ws + WS_S5A) + (size_t)li * 64 * 256 * 256, S5ROWS, 256, 256, S5K, 256, 4, 0}; S.init(S5ROWS, 256, G, obid());
              EpiBf16<0, 1> E{XS, 128, nullptr, 0}; pg8::gemm_phase(lds, g, S, E, wave); }
            GSYNC();
            const int tid_s = tid_of(wave);
            for (int idx = obid() * 512 + tid_s; idx < 65536; idx += G * 512) {
                const int p = idx & 63, b = (idx >> 6) & 15, grp = idx >> 10;
                const float* A16 = (const float*)(ws + WS_A16) + (size_t)((li * 64 + grp) * 64 + p) * 2; const float ar = A16[0], ai = A16[1];
                const size_t r0 = (size_t)grp * 4096 + b * 256; float hr = 0.f, hi_ = 0.f;
                const unsigned* XS32 = (const unsigned*)XS; unsigned* A232 = (unsigned*)A2;
                for (int c0 = 0; c0 < 256; c0 += 32) { unsigned xw[32];
#pragma unroll
                    for (int k = 0; k < 32; ++k) xw[k] = XS32[(r0 + c0 + k) * 64 + p];
#pragma unroll
                    for (int k = 0; k < 32; ++k) { A232[(r0 + c0 + k) * (S5K / 2) + 128 + p] = pk2(hr, hi_);
                        const float nr = ar * hr - ai * hi_ + bf_lo(xw[k]), ni = ar * hi_ + ai * hr + bf_hi(xw[k]); hr = nr; hi_ = ni; } }
            }
            GSYNC();
            { pg8::Gemm g{A2, (const bf16_t*)(ws + WS_S5B) + (size_t)li * 64 * 256 * S5K, S5ROWS, 256, S5K, S5K, S5K, 4, 0}; S.init(S5ROWS, 256, G, obid());
              EpiS5Y E{GS}; pg8::gemm_phase(lds, g, S, E, wave); }
            GSYNC();
            { pg8::Gemm g{GS, (const bf16_t*)(ws + WS_WGLU) + (size_t)li * 2048 * DM, MTOK, 2048, DM, 16, DM, -1, 1}; S.init(MTOK, 2048, G, obid());
              EpiGlu E{XN, ROWSS(2 * layer + 1)}; pg8::gemm_phase(lds, g, S, E, wave); }
            GSYNC();
            FINALIZE_RS(2 * layer + 1, 32);
        }
        { pg8::Gemm g{XN, (const bf16_t*)(ws + WS_W1) + (size_t)layer * DFF * DM, MTOK, DFF, DM, DM, DM, -1, 0}; S.init(MTOK, DFF, G, obid());
          EpiBf16<1, 2> E{HID, DFF, RSV(2 * layer + 1), 0}; pg8::gemm_phase(lds, g, S, E, wave); }
        GSYNC();
        { pg8::Gemm g{HID, (const bf16_t*)(ws + WS_W2) + (size_t)layer * DM * DFF, MTOK, DM, DFF, DFF, DFF, -1, 0}; S.init(MTOK, DM, G, obid());
          EpiResid E{XN, ROWSS(2 * layer + 2), (layer < DEPTH - 1) ? (float*)nullptr : out}; pg8::gemm_phase(lds, g, S, E, wave); }
        GSYNC();
        if (layer == 1) FINALIZE_RS(2 * layer + 2, 16);
    }

__global__ void __launch_bounds__(512, 2) fwd_mega(Args a_unused) {
    extern __shared__ __attribute__((aligned(16))) unsigned char lds_raw[];
    cg::grid_group grid = cg::this_grid();
    LAS unsigned char* lds = (LAS unsigned char*)lds_raw;
    {
        const unsigned __attribute__((address_space(4)))* kp = (const unsigned __attribute__((address_space(4)))*)__builtin_amdgcn_kernarg_segment_ptr();
        if (threadIdx.x < 52) ((LAS unsigned*)(lds + ARGTBL_OFF))[threadIdx.x] = kp[threadIdx.x];
        if (threadIdx.x >= 64 && threadIdx.x < 66) ((LAS unsigned*)(lds + ARGTBL_OFF + 256))[threadIdx.x - 64] = 0u;
        __syncthreads();
    }
    const Tbl a{(const LAS unsigned*)(lds + ARGTBL_OFF)};
    const int tid = threadIdx.x, lane = tid & 63, wave = __builtin_amdgcn_readfirstlane(tid >> 6);
    const int G = gridDim.x, gw = blockIdx.x * 8 + wave, ngw = G * 8;
    {
        if (blockIdx.x == 0) for (int e = threadIdx.x; e < XCD_BAR_WORDS; e += 512) __hip_atomic_store((unsigned*)ws + e, 0u, __ATOMIC_RELAXED, __HIP_MEMORY_SCOPE_AGENT);
        for (int it = blockIdx.x; it < 256; it += G) s5_prep(a, it >> 7, (it >> 1) & 63, (LAS char*)lds, it & 1);
        LAS float* scr = (LAS float*)(lds + wave * 16384);
        for (int i = 0; i < 2; ++i) {
            tr_matrix(a.in(3) + (size_t)i * DM * INC, DM, INC, (bf16_t*)(ws + WS_WIN) + (size_t)i * INP * DM, DM, 0, scr, gw, ngw, lane, a.in(1) + 2 * i * DM);
            tr_matrix(a.in(5) + (size_t)i * 256 * 768, 256, 768, (bf16_t*)(ws + WS_WUQ) + (size_t)i * 768 * 256, 256, 0, scr, gw, ngw, lane);
            tr_matrix(a.in(7) + (size_t)i * 128 * 1024, 128, 1024, (bf16_t*)(ws + WS_WUKV) + (size_t)i * 1024 * 128, 128, 0, scr, gw, ngw, lane);
            tr_matrix(a.in(12) + (size_t)i * DM * DM, DM, DM, (bf16_t*)(ws + WS_WO) + (size_t)i * DM * DM, DM, 0, scr, gw, ngw, lane);
            tr_matrix(a.in(21) + (size_t)i * DM * 2048, DM, 2048, (bf16_t*)(ws + WS_WGLU) + (size_t)i * 2048 * DM, DM, 1, scr, gw, ngw, lane);
        }
        for (int i = 0; i < DEPTH; ++i) {
            tr_matrix(a.in(22) + (size_t)i * DM * DFF, DM, DFF, (bf16_t*)(ws + WS_W1) + (size_t)i * DFF * DM, DM, 0, scr, gw, ngw, lane, a.in(2) + i * DM);
            tr_matrix(a.in(23) + (size_t)i * DFF * DM, DFF, DM, (bf16_t*)(ws + WS_W2) + (size_t)i * DM * DFF, DFF, 0, scr, gw, ngw, lane);
        }
        const int gt = blockIdx.x * 512 + tid, ngt = G * 512;
        for (int e = gt; e < 2 * (INP - INC) * DM / 8; e += ngt) {
            const int i = e / ((INP - INC) * DM / 8), r = e % ((INP - INC) * DM / 8);
            *(u32x4*)((bf16_t*)(ws + WS_WIN) + (size_t)i * INP * DM + (size_t)INC * DM + (size_t)r * 8) = (u32x4){0, 0, 0, 0}; }
        if (blockIdx.x == 1 % G && tid < 4) {
            const int li_ = tid >> 1, ty = tid & 1, d = ty ? 64 : 96; const float* gq = a.in(ty ? 10 : 8) + li_ * d; const float* gk = a.in(ty ? 11 : 9) + li_ * d;
            float mq = 0.f, mk = 0.f; for (int e = 0; e < d; ++e) { mq = fmaxf(mq, fabsf(gq[e])); mk = fmaxf(mk, fabsf(gk[e])); }
            ((int*)(ws + WS_FLAGS))[tid] = (sqrtf((float)d) * mq * mk * LOG2E < 64.f) ? 1 : 0; }
        cast_rows(a.in(0), XN, RSV(0), gw, ngw, lane);
        for (int e = gt; e < SEQ * 16; e += ngt) { const int pos = e >> 4, i = e & 15;
            const float inv = exp2f(-(float)i * (13.287712379549449f / 16.f)); float rev = ((float)pos * inv) * 0.15915494309189535f; rev -= rintf(rev);
            ((f32x2*)(ws + WS_ROPE))[e] = (f32x2){__builtin_amdgcn_cosf(rev), __builtin_amdgcn_sinf(rev)}; }
    }
    grid.sync();
    (void)xcd_barrier_post((unsigned*)ws, (volatile LAS unsigned*)(lds + ARGTBL_OFF + 256));

    run_layer<0>(a, lds, G, wave); run_layer<1>(a, lds, G, wave); run_layer<2>(a, lds, G, wave); run_layer<3>(a, lds, G, wave);
#undef ws
#undef out
#undef GSYNC
#undef FINALIZE_RS
}

extern "C" void kernel_launch(void* const* d_in, const int* in_sizes, int n_in, void* d_out, int out_size, void* d_ws, size_t ws_size, hipStream_t stream) {
    static int grid = 0;
    if (grid == 0) {
        if (n_in != 24 || out_size != MTOK * DM || ws_size < WS_END) { fprintf(stderr, "kernel_launch: unexpected shapes (n_in %d out %d ws %zu)\n", n_in, out_size, ws_size); grid = -1; return; }
        int dev = 0, cus = 0, per_cu = 0;
        hipGetDevice(&dev); hipDeviceGetAttribute(&cus, hipDeviceAttributeMultiprocessorCount, dev);
        hipFuncSetAttribute((const void*)fwd_mega, hipFuncAttributeMaxDynamicSharedMemorySize, LDS_BYTES);
        hipOccupancyMaxActiveBlocksPerMultiprocessor(&per_cu, (const void*)fwd_mega, 512, LDS_BYTES);
        if (per_cu < 1) { fprintf(stderr, "kernel_launch: occupancy query says %d blocks/CU\n", per_cu); per_cu = 1; }
        (void)hipGetLastError();
        grid = cus * 1;
    }
    if (grid < 0) return;
    Args a{};
    for (int i = 0; i < 24; ++i) a.in[i] = (const float*)d_in[i];
    a.out = (float*)d_out; a.ws = (unsigned char*)d_ws;
    void* args[] = {&a};
    hipError_t e = hipLaunchCooperativeKernel((const void*)fwd_mega, dim3(grid), dim3(512), args, LDS_BYTES, stream);
    if (e != hipSuccess) fprintf(stderr, "cooperative launch failed: %s (grid %d)\n", hipGetErrorString(e), grid);
}
```

```cpp
#include <hip/hip_runtime.h>
#include <hip/hip_cooperative_groups.h>
#include <cstdio>
#include <cstdint>
namespace cg = cooperative_groups;

#define LAS __attribute__((address_space(3)))
typedef unsigned short bf16_t;
typedef short bf16x8 __attribute__((ext_vector_type(8)));
typedef float f32x4 __attribute__((ext_vector_type(4)));
typedef float f32x16 __attribute__((ext_vector_type(16)));
typedef unsigned u32x4 __attribute__((ext_vector_type(4)));
typedef unsigned u32x2 __attribute__((ext_vector_type(2)));
typedef float f32x2 __attribute__((ext_vector_type(2)));

constexpr int DM = 1024, NB = 16, SEQ = 4096, MTOK = NB * SEQ, DEPTH = 4, DFF = 4096;
constexpr int INC = 1952, INP = 2048;
constexpr int C_CQ = 0, C_CKV = 256, C_KR = 384, C_QB = 416, C_KB = 928, C_VB = 1440;
constexpr float EPS = 1e-6f, LOG2E = 1.4426950408889634f;
constexpr int S5L = 16, S5NC = SEQ / S5L;
constexpr int S5ROWS = 64 * NB * S5NC;
constexpr int S5K = 384;

constexpr size_t MiB = 1u << 20;
constexpr size_t WS_WIN = 1 * MiB, WS_WUQ = 9 * MiB, WS_WUKV = 10 * MiB, WS_WO = 11 * MiB, WS_WGLU = 15 * MiB, WS_W1 = 23 * MiB, WS_W2 = 55 * MiB;
constexpr size_t WS_S5A = 87 * MiB, WS_S5B = 103 * MiB, WS_A16 = 127 * MiB, WS_ROPE = 128 * MiB, WS_KMEAN = 129 * MiB, WS_FLAGS = 129 * MiB + 512 * 1024;
constexpr size_t WS_XN = 130 * MiB;
constexpr size_t WS_BIG = 258 * MiB;
constexpr size_t WS_HID = WS_BIG, WS_PROJ = WS_BIG, WS_QR = WS_BIG + 256 * MiB, WS_KVR = WS_BIG + 352 * MiB;
constexpr size_t WS_A2 = WS_BIG, WS_XS = WS_BIG + 192 * MiB, WS_GS = WS_BIG + 256 * MiB;
constexpr size_t WS_KM = 770 * MiB, WS_OB = 866 * MiB, WS_ROWSS = 994 * MiB, WS_RS = 1010 * MiB, WS_END = 1011 * MiB;

constexpr int LDS_BYTES = 147456;

__device__ __forceinline__ unsigned f2bf(float f) { unsigned u = __builtin_bit_cast(unsigned, f); return (u + 0x7fffu + ((u >> 16) & 1u)) >> 16; }
__device__ __forceinline__ unsigned pk2(float lo, float hi) { return f2bf(lo) | (f2bf(hi) << 16); }
__device__ __forceinline__ unsigned cvtpk(float lo, float hi) { typedef __bf16 b2 __attribute__((ext_vector_type(2))); f32x2 v = {lo, hi}; b2 b = __builtin_convertvector(v, b2); return __builtin_bit_cast(unsigned, b); }
__device__ __forceinline__ float bf_lo(unsigned w) { return __builtin_bit_cast(float, w << 16); }
__device__ __forceinline__ float bf_hi(unsigned w) { return __builtin_bit_cast(float, w & 0xffff0000u); }
__device__ __forceinline__ int lane_id() { return (int)__builtin_amdgcn_mbcnt_hi(~0u, __builtin_amdgcn_mbcnt_lo(~0u, 0u)); }
__device__ __forceinline__ int tid_of(int wv) { int t = wv * 64 + lane_id(); asm volatile("" : "+v"(t)); return t; }
__device__ __forceinline__ float bperm(int srclane, float v) { return __builtin_bit_cast(float, __builtin_amdgcn_ds_bpermute(srclane << 2, __builtin_bit_cast(int, v))); }
__device__ __forceinline__ float shx(float v, int o, int lane) { return bperm(lane ^ o, v); }
__device__ __forceinline__ float wave_sum(float v, int lane) {
#pragma unroll
    for (int o = 1; o < 64; o <<= 1) v += shx(v, o, lane);
    return v;
}
__device__ __forceinline__ void unpack8(const u32x4 w, float* f) { f[0] = bf_lo(w.x); f[1] = bf_hi(w.x); f[2] = bf_lo(w.y); f[3] = bf_hi(w.y); f[4] = bf_lo(w.z); f[5] = bf_hi(w.z); f[6] = bf_lo(w.w); f[7] = bf_hi(w.w); }
__device__ __forceinline__ u32x4 pack8(const float* f) { u32x4 w; w.x = cvtpk(f[0], f[1]); w.y = cvtpk(f[2], f[3]); w.z = cvtpk(f[4], f[5]); w.w = cvtpk(f[6], f[7]); return w; }

namespace pg8 {
constexpr int BM = 256, BK = 64, HALF = 128, HTB = HALF * BK * 2, STAGE_BYTES = 8 * HTB, NXCD = 8, WGM = 4;
__host__ __device__ __forceinline__ int lds_byte(int r, int c) { const int st = (r >> 4) * 2 + (c >> 5), rr = r & 15, cc = c & 31, ob = rr * 64 + cc * 2; return st * 1024 + (ob ^ (((ob >> 9) & 1) << 5)); }
__host__ __device__ __forceinline__ void stage_rc(int b, int& R, int& C) { const int st = b / 1024, sb = b % 1024, swz = sb ^ (((sb >> 9) & 1) << 5); R = (st >> 1) * 16 + swz / 64; C = (st & 1) * 32 + (swz % 64) / 2; }
__host__ __device__ __forceinline__ int perm32(int rho) { const int n = rho >> 4, i = rho & 15; return 8 * (i >> 2) + 4 * n + (i & 3); }
struct Unit { int pm, pn; };
struct Gemm { const bf16_t* A; const bf16_t* Bt; int M, N, K, lda, ldb, bgrp, amode; };
struct StaticOrder {
    int nM, nN, nwg, G, c;
    __device__ void init(int M, int N, int G_, int c_) { nM = M / BM; nN = N / BM; nwg = nM * nN; G = G_; c = c_; }
    __device__ bool next(int i, Unit& u) const {
        const long L = (long)i * G + c; if (L >= nwg) return false;
        int wgid = (int)L; { const int q = nwg / NXCD, r = nwg % NXCD, xcd = wgid % NXCD, off = wgid / NXCD; wgid = (xcd < r ? xcd * (q + 1) : r * (q + 1) + (xcd - r) * q) + off; }
        const int nig = WGM * nN, gid = wgid / nig, fm = gid * WGM, gsz = (nM - fm) < WGM ? (nM - fm) : WGM;
        u.pm = fm + ((wgid % nig) % gsz); u.pn = (wgid % nig) / gsz; return true;
    }
};
template <class Epi>
__device__ __forceinline__ void gemm_phase(LAS unsigned char* lds, const Gemm g, const StaticOrder& S, const Epi& E, const int wv) {
    const int tid = tid_of(wv);
    const int wid = __builtin_amdgcn_readfirstlane(tid >> 6), lane = tid & 63, wr = wid >> 2, wc = wid & 3, fr = lane & 15, fq = lane >> 4;
    const int nt = g.K / BK;
    unsigned voffA[2], voffB[2];
#pragma unroll
    for (int i = 0; i < 2; ++i) { int R, C; stage_rc(tid * 16 + i * 8192, R, C); const int Rb = (R & ~31) + perm32(R & 31);
        voffA[i] = g.amode ? (unsigned)((C >> 4) * (g.M * 16) + R * 16 + (C & 15)) * 2u : (unsigned)(R * g.lda + C) * 2u; voffB[i] = (unsigned)(Rb * g.ldb + C) * 2u; }
    const size_t kstep = (size_t)(BK * 2), kstepA = g.amode ? (size_t)4 * g.M * 16 * 2 : kstep;
    const size_t hsA = (size_t)HALF * g.lda * 2, hsB = (size_t)HALF * g.ldb * 2, tsA = 2 * hsA, tsB = 2 * hsB;
    const unsigned ldsw = (unsigned)wid * 1024u;
    const int aoff = lds_byte(wr * 64 + fr, fq * 8), boff = lds_byte(wc * 32 + fr, fq * 8);
#define PG8_SA(b, h) (((b) * 2 + (h)) * HTB)
#define PG8_SB(b, h) ((4 + (b) * 2 + (h)) * HTB)
#define PG8_STAGE(bufoff, gbase, voff) do { _Pragma("unroll") for (int _i = 0; _i < 2; ++_i) \
        __builtin_amdgcn_global_load_lds((const unsigned*)((const char*)(gbase) + (voff)[_i]), (LAS unsigned*)(lds + (bufoff) + ldsw + _i * 8192), 16, 0, 0); } while (0)
#define PG8_LDA(dst, b, h) do { _Pragma("unroll") for (int m = 0; m < 4; ++m) _Pragma("unroll") for (int k = 0; k < 2; ++k) dst[m][k] = *(const LAS bf16x8*)(lds + PG8_SA(b, h) + aoff + m * 2048 + k * 1024); } while (0)
#define PG8_LDB(dst, b, h) do { _Pragma("unroll") for (int n = 0; n < 2; ++n) _Pragma("unroll") for (int k = 0; k < 2; ++k) dst[n][k] = *(const LAS bf16x8*)(lds + PG8_SB(b, h) + boff + n * 2048 + k * 1024); } while (0)
#define PG8_MMA(ai, bj, At, Bt) do { __builtin_amdgcn_s_setprio(1); _Pragma("unroll") for (int m = 0; m < 4; ++m) _Pragma("unroll") for (int n = 0; n < 2; ++n) _Pragma("unroll") for (int k = 0; k < 2; ++k) \
        acc[ai][bj][m][n] = __builtin_amdgcn_mfma_f32_16x16x32_bf16(Bt[n][k], At[m][k], acc[ai][bj][m][n], 0, 0, 0); __builtin_amdgcn_s_setprio(0); } while (0)
#define PG8_WAIT_V(n) asm volatile("s_waitcnt vmcnt(" #n ")" ::: "memory")
#define PG8_WAIT_L(n) asm volatile("s_waitcnt lgkmcnt(" #n ")" ::: "memory")
#define PG8_BAR __builtin_amdgcn_s_barrier()
#define PG8_SCHED __builtin_amdgcn_sched_barrier(0)
#define PG8_BIDX(u) (g.bgrp >= 0 ? ((u).pm >> g.bgrp) : (u).pn)
    Unit cur, nxt; int ui = 0;
    if (!S.next(0, cur)) return;
    f32x4 acc[2][2][4][2];
#pragma unroll
    for (int a = 0; a < 2; ++a)
#pragma unroll
        for (int b = 0; b < 2; ++b)
#pragma unroll
            for (int m = 0; m < 4; ++m)
#pragma unroll
                for (int n = 0; n < 2; ++n) acc[a][b][m][n] = (f32x4){0.f, 0.f, 0.f, 0.f};
    bf16x8 At[4][2], B0[2][2], B1[2][2];
    const char* cA = (const char*)g.A + (size_t)cur.pm * tsA; const char* cB = (const char*)g.Bt + (size_t)PG8_BIDX(cur) * tsB;
    PG8_STAGE(PG8_SB(0, 0), cB, voffB); PG8_STAGE(PG8_SB(0, 1), cB + hsB, voffB); PG8_STAGE(PG8_SA(0, 0), cA, voffA); PG8_STAGE(PG8_SA(0, 1), cA + hsA, voffA);
    if (wr == 1) PG8_BAR;
    PG8_WAIT_V(2); PG8_BAR;
    PG8_STAGE(PG8_SB(1, 0), cB + kstep, voffB); PG8_STAGE(PG8_SA(1, 0), cA + kstepA, voffA); PG8_STAGE(PG8_SB(1, 1), cB + hsB + kstep, voffB);
    PG8_WAIT_V(6); PG8_BAR;
    for (;;) {
        const bool has_next = S.next(ui + 1, nxt);
        const char* nA = has_next ? (const char*)g.A + (size_t)nxt.pm * tsA : cA; const char* nB = has_next ? (const char*)g.Bt + (size_t)PG8_BIDX(nxt) * tsB : cB;
#pragma unroll 1
        for (int t = 0; t < nt; t += 2) {
            const bool last = (t == nt - 2);
            const char* a1 = cA + (size_t)(t + 1) * kstepA;
            const char* a2 = last ? nA : cA + (size_t)(t + 2) * kstepA; const char* b2 = last ? nB : cB + (size_t)(t + 2) * kstep;
            const char* a3 = a2 + kstepA; const char* b3 = b2 + kstep;
            asm volatile("" : "+s"(a1), "+s"(a2), "+s"(b2), "+s"(a3), "+s"(b3));
            PG8_LDB(B0, 0, 0); PG8_LDB(B1, 0, 1); PG8_SCHED; PG8_LDA(At, 0, 0); PG8_STAGE(PG8_SA(1, 1), a1 + hsA, voffA);
            PG8_WAIT_V(8); PG8_WAIT_L(0); PG8_BAR; PG8_MMA(0, 0, At, B0); PG8_MMA(0, 1, At, B1); PG8_BAR; PG8_SCHED;
            PG8_LDA(At, 0, 1); PG8_STAGE(PG8_SB(0, 0), b2, voffB); PG8_STAGE(PG8_SB(0, 1), b2 + hsB, voffB); PG8_STAGE(PG8_SA(0, 0), a2, voffA);
            PG8_WAIT_V(8); PG8_WAIT_L(0); PG8_BAR; PG8_MMA(1, 0, At, B0); PG8_MMA(1, 1, At, B1); PG8_BAR; PG8_SCHED;
            PG8_LDB(B0, 1, 0); PG8_LDB(B1, 1, 1); PG8_SCHED; PG8_LDA(At, 1, 0); PG8_STAGE(PG8_SA(0, 1), a2 + hsA, voffA);
            PG8_WAIT_V(8); PG8_WAIT_L(0); PG8_BAR; PG8_MMA(0, 0, At, B0); PG8_MMA(0, 1, At, B1); PG8_BAR; PG8_SCHED;
            PG8_LDA(At, 1, 1); PG8_STAGE(PG8_SB(1, 0), b3, voffB); PG8_STAGE(PG8_SB(1, 1), b3 + hsB, voffB); PG8_STAGE(PG8_SA(1, 0), a3, voffA);
            PG8_WAIT_V(8); PG8_WAIT_L(0); PG8_BAR; PG8_MMA(1, 0, At, B0); PG8_MMA(1, 1, At, B1); PG8_BAR; PG8_SCHED;
        }
        if (wr == 0) PG8_BAR;
        E(acc, cur, wr, wc, fr, fq);
        if (!has_next) break;
#pragma unroll
        for (int a = 0; a < 2; ++a)
#pragma unroll
            for (int b = 0; b < 2; ++b)
#pragma unroll
                for (int m = 0; m < 4; ++m)
#pragma unroll
                    for (int n = 0; n < 2; ++n) acc[a][b][m][n] = (f32x4){0.f, 0.f, 0.f, 0.f};
        cur = nxt; cA = nA; cB = nB; ++ui;
        if (wr == 1) PG8_BAR;
    }
    PG8_WAIT_V(0);
    PG8_BAR;
#undef PG8_SA
#undef PG8_SB
#undef PG8_STAGE
#undef PG8_LDA
#undef PG8_LDB
#undef PG8_MMA
#undef PG8_WAIT_V
#undef PG8_WAIT_L
#undef PG8_BAR
#undef PG8_SCHED
#undef PG8_BIDX
}
}
using pg8::Unit;
typedef const f32x4 (&AccRef)[2][2][4][2];

__device__ __forceinline__ float row_rs(const float* part, int r, int nslots) {
    const float* p = part + (size_t)r * 32; float s;
    if (nslots == 1) s = p[0];
    else { f32x4 a = ((const f32x4*)p)[0];
        for (int k = 1; k < nslots / 4; ++k) a += ((const f32x4*)p)[k];
        s = (a.x + a.y) + (a.z + a.w); }
    return rsqrtf(s * (1.f / DM) + EPS);
}
template <int ACT, int NBJ> struct EpiBf16 {
    bf16_t* O; int ldc; const float* rowss; int nslots;
    __device__ __forceinline__ void operator()(AccRef acc, const Unit& u, int wr, int wc, int fr, int fq) const {
        const int row0 = u.pm * 256 + wr * 64 + fr, col0 = u.pn * 256 + wc * 32 + 8 * fq;
#pragma unroll
        for (int ai = 0; ai < 2; ++ai)
#pragma unroll
            for (int m = 0; m < 4; ++m) { bf16_t* rowp = O + (size_t)(row0 + ai * 128 + m * 16) * ldc + col0;
                const float rsc = rowss ? rowss[row0 + ai * 128 + m * 16] : 1.f;
#pragma unroll
                for (int bj = 0; bj < NBJ; ++bj) { f32x4 v0 = acc[ai][bj][m][0] * rsc, v1 = acc[ai][bj][m][1] * rsc;
                    if (ACT == 1) {
#pragma unroll
                        for (int e = 0; e < 4; ++e) { float a = fmaxf(v0[e], 0.f), b = fmaxf(v1[e], 0.f); v0[e] = a * a; v1[e] = b * b; } }
                    u32x4 w; w.x = cvtpk(v0[0], v0[1]); w.y = cvtpk(v0[2], v0[3]); w.z = cvtpk(v1[0], v1[1]); w.w = cvtpk(v1[2], v1[3]);
                    if (ACT == 1) __builtin_nontemporal_store(w, (u32x4*)(rowp + bj * 128)); else *(u32x4*)(rowp + bj * 128) = w; } }
    }
};
struct EpiResid {
    bf16_t* xb; float* rowss; float* outf;
    __device__ __forceinline__ void operator()(AccRef acc, const Unit& u, int wr, int wc, int fr, int fq) const {
        const int row0 = u.pm * 256 + wr * 64 + fr, col0 = u.pn * 256 + wc * 32 + 8 * fq, lane = fq * 16 + fr;
        u32x4 xin[2][4][2];
#pragma unroll
        for (int ai = 0; ai < 2; ++ai)
#pragma unroll
            for (int m = 0; m < 4; ++m)
#pragma unroll
                for (int bj = 0; bj < 2; ++bj) xin[ai][m][bj] = *(const u32x4*)(xb + (size_t)(row0 + ai * 128 + m * 16) * DM + col0 + bj * 128);
#pragma unroll
        for (int ai = 0; ai < 2; ++ai)
#pragma unroll
            for (int m = 0; m < 4; ++m) { const size_t off = (size_t)(row0 + ai * 128 + m * 16) * DM + col0; float ss = 0.f;
#pragma unroll
                for (int bj = 0; bj < 2; ++bj) {
                    float b[8]; unpack8(xin[ai][m][bj], b);
                    const f32x4 a0 = acc[ai][bj][m][0], a1 = acc[ai][bj][m][1];
                    float o[8];
#pragma unroll
                    for (int e = 0; e < 4; ++e) { o[e] = b[e] + a0[e]; o[4 + e] = b[4 + e] + a1[e]; }
                    if (outf) { *(f32x4*)(outf + off + bj * 128) = (f32x4){o[0], o[1], o[2], o[3]}; *(f32x4*)(outf + off + bj * 128 + 4) = (f32x4){o[4], o[5], o[6], o[7]}; }
                    else { *(u32x4*)(xb + off + bj * 128) = pack8(o);
#pragma unroll
                        for (int e = 0; e < 8; ++e) ss += o[e] * o[e]; } }
                if (!outf) { ss += shx(ss, 16, lane); ss += shx(ss, 32, lane); if (fq == 0) rowss[(size_t)(row0 + ai * 128 + m * 16) * 32 + u.pn * 4 + wc] = ss; } }
    }
};
struct EpiGlu {
    bf16_t* xb; float* rowss;
    __device__ __forceinline__ void operator()(AccRef acc, const Unit& u, int wr, int wc, int fr, int fq) const {
        const int row0 = u.pm * 256 + wr * 64 + fr, col0 = u.pn * 128 + wc * 32 + 8 * fq, lane = fq * 16 + fr;
        u32x4 xin[2][4];
#pragma unroll
        for (int ai = 0; ai < 2; ++ai)
#pragma unroll
            for (int m = 0; m < 4; ++m) xin[ai][m] = *(const u32x4*)(xb + (size_t)(row0 + ai * 128 + m * 16) * DM + col0);
#pragma unroll
        for (int ai = 0; ai < 2; ++ai)
#pragma unroll
            for (int m = 0; m < 4; ++m) { const size_t off = (size_t)(row0 + ai * 128 + m * 16) * DM + col0; float ss = 0.f;
                float b[8], o[8]; unpack8(xin[ai][m], b);
#pragma unroll
                for (int n = 0; n < 2; ++n) { const f32x4 v = acc[ai][0][m][n], gt = acc[ai][1][m][n];
#pragma unroll
                    for (int e = 0; e < 4; ++e) { o[4 * n + e] = b[4 * n + e] + v[e] * __builtin_amdgcn_rcpf(1.f + __builtin_amdgcn_exp2f(-gt[e] * LOG2E)); ss += o[4 * n + e] * o[4 * n + e]; } }
                *(u32x4*)(xb + off) = pack8(o);
                ss += shx(ss, 16, lane); ss += shx(ss, 32, lane); if (fq == 0) rowss[(size_t)(row0 + ai * 128 + m * 16) * 32 + u.pn * 4 + wc] = ss; }
    }
};
struct EpiS5Y {
    bf16_t* G;
    __device__ __forceinline__ void operator()(AccRef acc, const Unit& u, int wr, int wc, int fr, int fq) const {
        const int row0 = u.pm * 256 + wr * 64 + fr;
#pragma unroll
        for (int ai = 0; ai < 2; ++ai)
#pragma unroll
            for (int m = 0; m < 4; ++m) { const int r = row0 + ai * 128 + m * 16; const int grp = r >> 12, rc = r & 4095, b = rc >> 8, c = rc & 255;
#pragma unroll
                for (int bj = 0; bj < 2; ++bj) { const int n0 = bj * 128 + wc * 32 + 8 * fq, l = n0 >> 4, o0 = n0 & 15;
                    float y[8];
#pragma unroll
                    for (int e = 0; e < 4; ++e) { y[e] = acc[ai][bj][m][0][e]; y[4 + e] = acc[ai][bj][m][1][e]; }
#pragma unroll
                    for (int e = 0; e < 8; ++e) { const float v = y[e], t = 0.7978845608f * (v + 0.044715f * v * v * v); y[e] = v * __builtin_amdgcn_rcpf(1.f + __builtin_amdgcn_exp2f(-2.f * LOG2E * t)); }
                    *(u32x4*)(G + ((size_t)grp * MTOK + (b * SEQ + c * S5L + l)) * 16 + o0) = pack8(y);     asm volatile("" ::: "memory"); } }
    }
};

__device__ __forceinline__ int crow(int r, int hi) { return (r & 3) + 8 * (r >> 2) + 4 * hi; }
typedef short v4i16_t __attribute__((ext_vector_type(4)));
__device__ __forceinline__ v4i16_t vtr(const LAS char* p) { return __builtin_amdgcn_ds_read_tr16_b64_v4i16((LAS v4i16_t*)p); }

__device__ __forceinline__ float swap32_other(float v, int hi) {
    const unsigned u = __builtin_bit_cast(unsigned, v);
    auto rr = __builtin_amdgcn_permlane32_swap(u, u, false, false);
    return __builtin_bit_cast(float, hi ? rr[0] : rr[1]);
}
template <int DK, bool MOBA>
__device__ __forceinline__ void attn_head(const bf16_t* __restrict__ Q, int ldq, const bf16_t* __restrict__ K, int ldk, const bf16_t* __restrict__ V, int ldv,
                                          bf16_t* __restrict__ O, int ldo, const bf16_t* __restrict__ kmean, LAS char* lds, unsigned qmask, const int wv, const bool fast) {
    constexpr int KS = DK * 2 + 16, VS = 192, KCH = DK / 8, NDS = DK / 16;
    constexpr int KBUF = 64 * KS, VBUF = 64 * VS;
    constexpr int VOFF = 2 * KBUF;
    const int tid = tid_of(wv);
    const int lane = tid & 63, wid = __builtin_amdgcn_readfirstlane(tid >> 6), r32 = lane & 31, hi = lane >> 5;
    const int kr0 = tid / KCH, kc0 = tid % KCH, kr1 = (tid + 512) / KCH, kc1 = (tid + 512) % KCH;
    const bool k2 = (DK == 96) && (tid + 512 < 64 * KCH);
    const int vr = tid >> 3, vc = tid & 7;
    const int i16 = lane & 15, cb = (lane >> 4) & 1;
    const int vlane = (4 * hi + (i16 >> 2)) * VS + (16 * cb + 4 * (i16 & 3)) * 2;
    const short one_b = (r32 == 0) ? (short)0x3F80 : (short)0;
    const bf16x8 onesf = (bf16x8){one_b, one_b, one_b, one_b, one_b, one_b, one_b, one_b};
#define AT_LOADK(t_) do { const size_t rb_ = (size_t)(t_) * 64; kg0 = *(const u32x4*)(K + (rb_ + kr0) * ldk + kc0 * 8); if (k2) kg1 = *(const u32x4*)(K + (rb_ + kr1) * ldk + kc1 * 8); } while (0)
#define AT_LOADV(t_) do { const size_t rb_ = (size_t)(t_) * 64; vg = *(const u32x4*)(V + (rb_ + vr) * ldv + vc * 8); } while (0)
#define AT_STK(slot_) do { LAS char* kb_ = lds + (slot_) * KBUF; *(LAS u32x4*)(kb_ + kr0 * KS + kc0 * 16) = kg0; if (k2) *(LAS u32x4*)(kb_ + kr1 * KS + kc1 * 16) = kg1; } while (0)
#define AT_STV(slot_) do { *(LAS u32x4*)(lds + VOFF + (slot_) * VBUF + vr * VS + vc * 16) = vg; } while (0)
#define AT_QK(P0_, P1_, slot_) do { const LAS char* kb_ = lds + (slot_) * KBUF; \
        _Pragma("unroll") for (int ds = 0; ds < NDS; ++ds) { \
            const bf16x8 ka_ = *(const LAS bf16x8*)(kb_ + r32 * KS + (ds * 16 + hi * 8) * 2); \
            const bf16x8 kc_ = *(const LAS bf16x8*)(kb_ + (32 + r32) * KS + (ds * 16 + hi * 8) * 2); \
            if (ds == 0) { P0_ = __builtin_amdgcn_mfma_f32_32x32x16_bf16(ka_, qf[0], MOBA ? cbias : zero16, 0, 0, 0); P1_ = __builtin_amdgcn_mfma_f32_32x32x16_bf16(kc_, qf[0], MOBA ? cbias : zero16, 0, 0, 0); } \
            else { P0_ = __builtin_amdgcn_mfma_f32_32x32x16_bf16(ka_, qf[ds], P0_, 0, 0, 0); P1_ = __builtin_amdgcn_mfma_f32_32x32x16_bf16(kc_, qf[ds], P1_, 0, 0, 0); } } } while (0)
#define AT_CBIAS(tt_) do { if (MOBA) { const float b_ = ((tt_) < 4 * qb && !((sel >> ((tt_) >> 2)) & 1u)) ? -INFINITY : 0.f; \
        _Pragma("unroll") for (int r = 0; r < 16; ++r) cbias[r] = b_; } } while (0)
    const f32x16 zero16 = (f32x16){0.f, 0.f, 0.f, 0.f, 0.f, 0.f, 0.f, 0.f, 0.f, 0.f, 0.f, 0.f, 0.f, 0.f, 0.f, 0.f};
    if (wid < 4) __builtin_amdgcn_s_setprio(2);
    for (int qb = 15; qb >= 0; --qb) {
        if (!((qmask >> qb) & 1u)) continue;
        const int qrow = qb * 256 + wid * 32 + r32;
        bf16x8 qf[NDS];
#pragma unroll
        for (int ds = 0; ds < NDS; ++ds) qf[ds] = *(const bf16x8*)(Q + (size_t)qrow * ldq + ds * 16 + hi * 8);
        u32x4 kg0, kg1 = (u32x4){0, 0, 0, 0}, vg, kh0, kh1 = (u32x4){0, 0, 0, 0};
        AT_LOADK(0); AT_LOADV(0);
        kh0 = *(const u32x4*)(K + (size_t)(64 + kr0) * ldk + kc0 * 8); if (k2) kh1 = *(const u32x4*)(K + (size_t)(64 + kr1) * ldk + kc1 * 8);
        unsigned sel = 0;
        if (MOBA) {
            if (qb > 0) {
                f32x16 ga = zero16;
#pragma unroll
                for (int ds = 0; ds < 4; ++ds) { const bf16x8 a = *(const bf16x8*)(kmean + (r32 & 15) * 64 + ds * 16 + hi * 8); ga = __builtin_amdgcn_mfma_f32_32x32x16_bf16(a, qf[ds], ga, 0, 0, 0); }
                float gv[16];
#pragma unroll
                for (int r = 0; r < 8; ++r) { const float mine = ga[r], other = swap32_other(mine, hi); const int blk = (r & 3) + 8 * (r >> 2);
                    gv[blk] = hi ? other : mine; gv[blk + 4] = hi ? mine : other; }
#pragma unroll
                for (int j = 0; j < 16; ++j) if (j >= qb) gv[j] = -INFINITY;
#pragma unroll
                for (int it = 0; it < 3; ++it) { float best = -INFINITY; int bi = 0;
#pragma unroll
                    for (int j = 0; j < 16; ++j) if (gv[j] > best) { best = gv[j]; bi = j; }
                    if (best > -INFINITY) { sel |= 1u << bi;
#pragma unroll
                        for (int j = 0; j < 16; ++j) if (j == bi) gv[j] = -INFINITY; } }
            }
        }
        float mref = 0.f; f32x16 o0 = zero16, o1 = zero16, o2 = zero16, cbias = zero16;
        const int nt = 4 * (qb + 1);
        AT_STK(0); AT_STV(0);
        { LAS char* kb_ = lds + KBUF; *(LAS u32x4*)(kb_ + kr0 * KS + kc0 * 16) = kh0; if (k2) *(LAS u32x4*)(kb_ + kr1 * KS + kc1 * 16) = kh1; }
        __syncthreads();
        f32x16 pa0, pa1, pb0, pb1;
        AT_CBIAS(0);
        AT_QK(pa0, pa1, 0);
#define AT_STEP(HASNEXT, FAST, C0, C1, N0, N1) do { \
            const LAS char* vb = lds + VOFF + (t & 1) * VBUF; \
            if (t + 2 < nt) AT_LOADK(t + 2); \
            if (t + 1 < nt) AT_LOADV(t + 1); \
            if (!(FAST)) { if (__builtin_expect(__ballot(mref != 0.f) != 0ull, 0)) { _Pragma("unroll") for (int r = 0; r < 16; ++r) { C0[r] -= mref; C1[r] -= mref; } } } \
            if (t >= 4 * qb) { const int qrel = 32 * wid + r32, tl = t - 4 * qb; \
                _Pragma("unroll") for (int r = 0; r < 16; ++r) { const int key = 64 * tl + crow(r, hi); if (key > qrel) C0[r] = -INFINITY; if (key + 32 > qrel) C1[r] = -INFINITY; } } \
            if (!(FAST)) { \
                float ma = __builtin_fmaxf(__builtin_fmaxf(C0[0], C0[1]), C1[0]), mb = __builtin_fmaxf(__builtin_fmaxf(C0[2], C0[3]), C1[1]); \
                ma = __builtin_fmaxf(__builtin_fmaxf(ma, C1[2]), C1[3]); \
                _Pragma("unroll") for (int r = 4; r < 16; r += 4) { ma = __builtin_fmaxf(__builtin_fmaxf(ma, C0[r]), C0[r + 1]); mb = __builtin_fmaxf(__builtin_fmaxf(mb, C0[r + 2]), C0[r + 3]); \
                    ma = __builtin_fmaxf(__builtin_fmaxf(ma, C1[r]), C1[r + 1]); mb = __builtin_fmaxf(__builtin_fmaxf(mb, C1[r + 2]), C1[r + 3]); } \
                float mx = __builtin_fmaxf(ma, mb); mx = __builtin_fmaxf(mx, swap32_other(mx, hi)); \
                if (__builtin_expect(__ballot(mx > 20.0f) != 0ull, 0)) { \
                    const float dl = __builtin_fmaxf(mx, 0.f); mref += dl; \
                    _Pragma("unroll") for (int r = 0; r < 16; ++r) { C0[r] -= dl; C1[r] -= dl; } \
                    const float alpha = __builtin_amdgcn_exp2f(-dl); \
                    _Pragma("unroll") for (int r = 0; r < 16; ++r) { o0[r] *= alpha; o1[r] *= alpha; o2[r] *= alpha; } \
                } } \
            if (HASNEXT) { if (((t + 1) & 3) == 0) AT_CBIAS(t + 1); AT_QK(N0, N1, (t + 1) & 1); } \
            if (64 * (t - 4 * qb) <= 32 * wid + 31) {     \
            _Pragma("unroll") for (int r = 0; r < 16; ++r) { C0[r] = __builtin_amdgcn_exp2f(C0[r]); C1[r] = __builtin_amdgcn_exp2f(C1[r]); } \
            _Pragma("unroll") for (int s = 0; s < 4; ++s) { \
                u32x4 pw; \
                if (s == 0) pw = (u32x4){cvtpk(C0[0], C0[1]), cvtpk(C0[2], C0[3]), cvtpk(C0[4], C0[5]), cvtpk(C0[6], C0[7])}; \
                else if (s == 1) pw = (u32x4){cvtpk(C0[8], C0[9]), cvtpk(C0[10], C0[11]), cvtpk(C0[12], C0[13]), cvtpk(C0[14], C0[15])}; \
                else if (s == 2) pw = (u32x4){cvtpk(C1[0], C1[1]), cvtpk(C1[2], C1[3]), cvtpk(C1[4], C1[5]), cvtpk(C1[6], C1[7])}; \
                else pw = (u32x4){cvtpk(C1[8], C1[9]), cvtpk(C1[10], C1[11]), cvtpk(C1[12], C1[13]), cvtpk(C1[14], C1[15])}; \
                const bf16x8 pa = __builtin_bit_cast(bf16x8, pw); \
                const LAS char* vp = vb + vlane + (16 * s) * VS; \
                const v4i16_t a0 = vtr(vp), a1 = vtr(vp + 8 * VS), b0 = vtr(vp + 64), b1 = vtr(vp + 8 * VS + 64); \
                const bf16x8 va = (bf16x8){a0[0], a0[1], a0[2], a0[3], a1[0], a1[1], a1[2], a1[3]}; \
                const bf16x8 vb8 = (bf16x8){b0[0], b0[1], b0[2], b0[3], b1[0], b1[1], b1[2], b1[3]}; \
                o0 = __builtin_amdgcn_mfma_f32_32x32x16_bf16(va, pa, o0, 0, 0, 0); \
                o1 = __builtin_amdgcn_mfma_f32_32x32x16_bf16(vb8, pa, o1, 0, 0, 0); \
                o2 = __builtin_amdgcn_mfma_f32_32x32x16_bf16(onesf, pa, o2, 0, 0, 0); \
            } } \
            if (t + 2 < nt) AT_STK(t & 1); \
            if (t + 1 < nt) AT_STV((t + 1) & 1); \
            asm volatile("s_waitcnt lgkmcnt(0)" ::: "memory"); __builtin_amdgcn_s_barrier(); asm volatile("" ::: "memory");     \
        } while (0)
        int t = 0;
        if (fast) {
            for (; t < nt - 2; ) { AT_STEP(true, true, pa0, pa1, pb0, pb1); ++t; AT_STEP(true, true, pb0, pb1, pa0, pa1); ++t; }
            AT_STEP(true, true, pa0, pa1, pb0, pb1); ++t; AT_STEP(false, true, pb0, pb1, pa0, pa1);
        } else {
            for (; t < nt - 2; ) { AT_STEP(true, false, pa0, pa1, pb0, pb1); ++t; AT_STEP(true, false, pb0, pb1, pa0, pa1); ++t; }
            AT_STEP(true, false, pa0, pa1, pb0, pb1); ++t; AT_STEP(false, false, pb0, pb1, pa0, pa1);
        }
#undef AT_STEP
        const float lv = o2[0], lo_ = swap32_other(lv, hi), ltot = hi ? lo_ : lv, inv = 1.f / ltot;
        bf16_t* orow = O + (size_t)qrow * ldo + 4 * hi;
#pragma unroll
        for (int g4 = 0; g4 < 4; ++g4) {
            u32x2 w0, w1;
            w0.x = cvtpk(o0[4 * g4] * inv, o0[4 * g4 + 1] * inv); w0.y = cvtpk(o0[4 * g4 + 2] * inv, o0[4 * g4 + 3] * inv);
            w1.x = cvtpk(o1[4 * g4] * inv, o1[4 * g4 + 1] * inv); w1.y = cvtpk(o1[4 * g4 + 2] * inv, o1[4 * g4 + 3] * inv);
            *(u32x2*)(orow + 8 * g4) = w0; *(u32x2*)(orow + 32 + 8 * g4) = w1;
        }
    }
    __builtin_amdgcn_s_setprio(0);
#undef AT_LOADK
#undef AT_LOADV
#undef AT_STK
#undef AT_STV
#undef AT_QK
#undef AT_CBIAS
}

#define XB_TMO      128
#define XB_XCNT(j)  (256  + 64 * (j))
#define XB_XSUB(j)  (1280 + 64 * (j))
#define XB_XGEN(j)  (2304 + 64 * (j))
#define XB_TOP      3328
#define XB_TOPGEN   3392
#define XCD_BAR_WORDS 3456
#define XB_SPIN_CAP (1u << 18)
__device__ __forceinline__ unsigned xb_ld(unsigned* p)              { return __hip_atomic_load(p, __ATOMIC_RELAXED, __HIP_MEMORY_SCOPE_AGENT); }
__device__ __forceinline__ unsigned xb_add(unsigned* p, unsigned v) { return __hip_atomic_fetch_add(p, v, __ATOMIC_RELAXED, __HIP_MEMORY_SCOPE_AGENT); }
__device__ __forceinline__ unsigned xb_xcc_id() { return (unsigned)__builtin_amdgcn_s_getreg((3 << 11) | 20) & 0xFu; }
#define XB_SPIN(cond, bar) do { unsigned _sp = 0; while (cond) { __builtin_amdgcn_s_sleep(1); \
    if ((++_sp & 255u) == 0u) { if (xb_ld(&(bar)[XB_TMO])) break; if (_sp > XB_SPIN_CAP) { atomicAdd(&(bar)[XB_TMO], 1u); break; } } } } while (0)
struct XcdBarrier { unsigned* bar; unsigned x; volatile LAS unsigned* st; };
__device__ __forceinline__ XcdBarrier xcd_barrier_post(unsigned* bar, volatile LAS unsigned* st) {
    XcdBarrier b; b.bar = bar; b.x = xb_xcc_id(); b.st = st;
    if (threadIdx.x == 0) (void)xb_add(&bar[XB_XCNT(b.x)], 1u);
    return b;
}
__device__ __forceinline__ void xcd_barrier_complete(unsigned* bar, unsigned x, unsigned& nloc, unsigned& nx) {
    const unsigned G = gridDim.x * gridDim.y * gridDim.z;
    unsigned sum, cnt, mine, sp = 0u;
    for (;;) {
        sum = 0u; cnt = 0u; mine = 0u;
#pragma unroll
        for (unsigned j = 0; j < 16; ++j) { const unsigned c = xb_ld(&bar[XB_XCNT(j)]); sum += c; cnt += (c > 0u) ? 1u : 0u; mine = (j == x) ? c : mine; }
        if (sum == G) break;
        __builtin_amdgcn_s_sleep(1);
        if ((++sp & 255u) == 0u) { if (xb_ld(&bar[XB_TMO])) break; if (sp > XB_SPIN_CAP) { atomicAdd(&bar[XB_TMO], 1u); break; } }
    }
    nloc = mine > 0u ? mine : 1u; nx = cnt > 0u ? cnt : 1u;
}
__device__ __forceinline__ void xcd_barrier(const XcdBarrier& b, const int wv) {
    asm volatile("s_waitcnt vmcnt(0)" ::: "memory");
    __syncthreads();
    const int t0 = tid_of(wv);
    if (t0 == 0) {
        unsigned* bar = b.bar;
        __builtin_amdgcn_s_waitcnt(0);
        unsigned nloc = b.st[0], nx = b.st[1];
        if (nloc == 0u) { xcd_barrier_complete(bar, b.x, nloc, nx); b.st[0] = nloc; b.st[1] = nx; }
        const unsigned old = xb_add(&bar[XB_XSUB(b.x)], 1u);
        const unsigned gen = old / nloc;
        if (old + 1u == (gen + 1u) * nloc) {
            __builtin_amdgcn_fence(__ATOMIC_RELEASE, "agent");
            asm volatile("s_waitcnt vmcnt(0)" ::: "memory");
            const unsigned og = xb_add(&bar[XB_TOP], 1u);
            const unsigned tg = og / nx;
            if (og + 1u == (tg + 1u) * nx) xb_add(&bar[XB_TOPGEN], 1u);
            else XB_SPIN(xb_ld(&bar[XB_TOPGEN]) == tg, bar);
            __builtin_amdgcn_fence(__ATOMIC_ACQUIRE, "agent");
            xb_add(&bar[XB_XGEN(b.x)], 1u);
            asm volatile("s_waitcnt vmcnt(0)" ::: "memory");
        } else {
            XB_SPIN(xb_ld(&bar[XB_XGEN(b.x)]) == gen, bar);
            __builtin_amdgcn_fence(__ATOMIC_ACQUIRE, "agent");
            asm volatile("s_waitcnt vmcnt(0)" ::: "memory");
        }
    }
    __syncthreads();
}

__device__ __forceinline__ int obid() { int b = blockIdx.x; asm volatile("" : "+s"(b)); return b; }
struct Args { const float* in[24]; float* out; unsigned char* ws; };
constexpr int ARGTBL_OFF = 139264;
struct Tbl {
    const LAS unsigned* t;
    __device__ __forceinline__ unsigned long long q(int i) const { const LAS unsigned* p = t; asm volatile("" : "+v"(p)); const unsigned lo = __builtin_amdgcn_readfirstlane(p[2 * i]), hi = __builtin_amdgcn_readfirstlane(p[2 * i + 1]); return ((unsigned long long)hi << 32) | lo; }
    __device__ __forceinline__ const float* in(int i) const { return (const float*)(const __attribute__((address_space(1))) float*)q(i); }
    __device__ __forceinline__ float* out() const { return (float*)(__attribute__((address_space(1))) float*)q(24); }
    __device__ __forceinline__ unsigned char* ws() const { return (unsigned char*)(__attribute__((address_space(1))) unsigned char*)q(25); }
};

__device__ __forceinline__ void tr_item(const float* __restrict__ W, int N, bf16_t* __restrict__ WT, int ldt, int drow0, LAS float* scr, int k0, int n0, int lane, const float* __restrict__ gk) {
#pragma unroll
    for (int i = 0; i < 32; ++i) { const int kk = 2 * i + (lane >> 5); scr[kk * 33 + (lane & 31)] = W[(size_t)(k0 + kk) * N + n0 + (lane & 31)] * (gk ? gk[k0 + kk] : 1.f); }
    asm volatile("s_waitcnt lgkmcnt(0)" ::: "memory");
    const int c = lane & 7;
#pragma unroll
    for (int j = 0; j < 4; ++j) { const int n = (lane >> 3) + 8 * j; const LAS float* s = scr + (8 * c) * 33 + n;
        u32x4 o; o.x = pk2(s[0], s[33]); o.y = pk2(s[2 * 33], s[3 * 33]); o.z = pk2(s[4 * 33], s[5 * 33]); o.w = pk2(s[6 * 33], s[7 * 33]);
        *(u32x4*)(WT + (size_t)(drow0 + n) * ldt + k0 + 8 * c) = o; }
    asm volatile("s_waitcnt lgkmcnt(0)" ::: "memory");
}
__device__ __forceinline__ void tr_matrix(const float* W, int K, int N, bf16_t* WT, int ldt, int mode, LAS float* scr, int gw, int ngw, int lane, const float* gk = nullptr) {
    const int nblk = N / 32, nitems = (K / 64) * nblk;
    for (int it = gw; it < nitems; it += ngw) { const int kb = it / nblk, nb = it % nblk, n0 = 32 * nb;
        int drow0 = n0;
        if (mode == 1) { const int nn = n0 & 1023; drow0 = 256 * (nn >> 7) + (nn & 127) + ((n0 >> 10) ? 128 : 0); }
        tr_item(W, N, WT, ldt, drow0, scr, 64 * kb, n0, lane, gk); }
}

__device__ __forceinline__ void s5_prep(const Tbl a, int layer_i, int grp, LAS char* lds, const int part) {
    LAS f32x2* apow = (LAS f32x2*)lds;
    LAS f32x2* bb = apow + 17 * 64;
    LAS f32x2* cc = bb + 64 * 16;
    LAS float* ker = (LAS float*)(cc + 16 * 64);
    const int tid = threadIdx.x;
    const float* lam_re = a.in(13) + (size_t)(layer_i * 64 + grp) * 64; const float* lam_im = a.in(14) + (size_t)(layer_i * 64 + grp) * 64;
    const float dt = expf(a.in(15)[layer_i * 64 + grp]);
    const float* b_re = a.in(16) + (size_t)(layer_i * 64 + grp) * 1024; const float* b_im = a.in(17) + (size_t)(layer_i * 64 + grp) * 1024;
    const float* c_re = a.in(18) + (size_t)(layer_i * 64 + grp) * 1024; const float* c_im = a.in(19) + (size_t)(layer_i * 64 + grp) * 1024;
    const float* dsk = a.in(20) + (size_t)layer_i * DM + grp * 16;
    for (int e = tid; e < 17 * 64; e += 512) { const int m = e >> 6, p = e & 63; const float lr = lam_re[p], li = lam_im[p];
        const float mag = expf(lr * dt * (float)m); float rev = (li * dt * (float)m) * 0.15915494309189535f; rev -= rintf(rev);
        apow[e] = (f32x2){mag * __builtin_amdgcn_cosf(rev), mag * __builtin_amdgcn_sinf(rev)}; }
    __syncthreads();
    for (int e = tid; e < 1024; e += 512) { const int p = e >> 4; const float lr = lam_re[p], li = lam_im[p];
        const f32x2 a1 = apow[64 + p]; const float nr = a1.x - 1.f, ni = a1.y, den = 1.f / (lr * lr + li * li);
        const float cr = (nr * lr + ni * li) * den, ci = (ni * lr - nr * li) * den;
        const float br = b_re[e], bi = b_im[e]; bb[e] = (f32x2){cr * br - ci * bi, cr * bi + ci * br}; }
    if (part == 0 && tid < 64) { float* A16 = (float*)(a.ws() + WS_A16) + (size_t)((layer_i * 64 + grp) * 64 + tid) * 2; A16[0] = apow[16 * 64 + tid].x; A16[1] = apow[16 * 64 + tid].y; }
    if (part == 1) for (int e = tid; e < 1024; e += 512) cc[e] = (f32x2){c_re[e], c_im[e]};
    __syncthreads();
    if (part == 1) {
    for (int e = tid; e < 4096; e += 512) { const int m = e >> 8, o = (e >> 4) & 15, i = e & 15; float s = 0.f;
        for (int p = 0; p < 64; ++p) { const f32x2 c = cc[o * 64 + p], ap = apow[m * 64 + p], b = bb[p * 16 + i];
            const float tr = c.x * ap.x - c.y * ap.y, ti = c.x * ap.y + c.y * ap.x; s += tr * b.x - ti * b.y; }
        if (m == 0 && o == i) s += dsk[o];
        ker[e] = s; }
    __syncthreads();
    bf16_t* BtB = (bf16_t*)(a.ws() + WS_S5B) + (size_t)(layer_i * 64 + grp) * 256 * S5K;
    for (int ch = tid; ch < 256 * 48; ch += 512) { const int n = ch / 48, kc = ch % 48, l = n >> 4, o = n & 15, k0 = kc * 8; float v[8];
        if (k0 < 256) { const int j = k0 >> 4, i0 = k0 & 15;
#pragma unroll
            for (int e = 0; e < 8; ++e) v[e] = (l >= j) ? ker[((l - j) * 16 + o) * 16 + i0 + e] : 0.f; }
        else {
#pragma unroll
            for (int e = 0; e < 8; ++e) { const int kk = k0 - 256 + e, p = kk >> 1; const f32x2 c = cc[o * 64 + p], ap = apow[(l + 1) * 64 + p];
                v[e] = (kk & 1) ? -(c.x * ap.y + c.y * ap.x) : (c.x * ap.x - c.y * ap.y); } }
        u32x4 w; w.x = pk2(v[0], v[1]); w.y = pk2(v[2], v[3]); w.z = pk2(v[4], v[5]); w.w = pk2(v[6], v[7]);
        *(u32x4*)(BtB + (size_t)n * S5K + k0) = w; }
    } else {
    bf16_t* BtA = (bf16_t*)(a.ws() + WS_S5A) + (size_t)(layer_i * 64 + grp) * 256 * 256;
    for (int ch = tid; ch < 256 * 32; ch += 512) { const int n = ch >> 5, kc = ch & 31, k0 = kc * 8, j = k0 >> 4, i0 = k0 & 15; float v[8];
        if (n < 128) { const int p = n >> 1; const f32x2 ap = apow[(15 - j) * 64 + p];
#pragma unroll
            for (int e = 0; e < 8; ++e) { const f32x2 b = bb[p * 16 + i0 + e]; v[e] = (n & 1) ? (ap.x * b.y + ap.y * b.x) : (ap.x * b.x - ap.y * b.y); } }
        else {
#pragma unroll
            for (int e = 0; e < 8; ++e) v[e] = 0.f; }
        u32x4 w; w.x = pk2(v[0], v[1]); w.y = pk2(v[2], v[3]); w.z = pk2(v[4], v[5]); w.w = pk2(v[6], v[7]);
        *(u32x4*)(BtA + (size_t)n * 256 + k0) = w; }
    }
    __syncthreads();
}

__device__ __forceinline__ void cast_rows(const float* __restrict__ x, bf16_t* __restrict__ xb, float* __restrict__ rowss, int gw, int ngw, int lane) {
    asm volatile("" : "+v"(lane)); asm volatile("" : "+s"(gw));
    for (int m = gw; m < MTOK; m += ngw) {
        const f32x4* xr = (const f32x4*)(x + (size_t)m * DM) + lane; f32x4 v[4]; float s = 0.f;
#pragma unroll
        for (int j = 0; j < 4; ++j) { v[j] = xr[64 * j]; s += (v[j].x * v[j].x + v[j].y * v[j].y) + (v[j].z * v[j].z + v[j].w * v[j].w); }
        s = wave_sum(s, lane);
        u32x2* o8 = (u32x2*)(xb + (size_t)m * DM) + lane;
#pragma unroll
        for (int j = 0; j < 4; ++j) { u32x2 w; w.x = cvtpk(v[j].x, v[j].y); w.y = cvtpk(v[j].z, v[j].w); o8[64 * j] = w; }
        if (lane == 0) rowss[m] = rsqrtf(s * (1.f / DM) + EPS);
    }
}
__device__ __forceinline__ void norm_rows_s5(const bf16_t* __restrict__ xb, const float* __restrict__ rowss, int nslots, const float* __restrict__ g, bf16_t* __restrict__ A2, int gw, int ngw, int lane) {
    asm volatile("" : "+v"(lane)); asm volatile("" : "+s"(gw));
    float gv[16];
#pragma unroll
    for (int j = 0; j < 4; ++j) { const f32x4 t = ((const f32x4*)g)[4 * lane + j]; gv[4 * j] = t.x; gv[4 * j + 1] = t.y; gv[4 * j + 2] = t.z; gv[4 * j + 3] = t.w; }
    for (int m = gw; m < MTOK; m += ngw) {
        const u32x4* xr = (const u32x4*)(xb + (size_t)m * DM) + 2 * lane; float v[16];
        unpack8(xr[0], v); unpack8(xr[1], v + 8);
        float sp = ((lane & 31) < nslots) ? rowss[(size_t)m * 32 + (lane & 31)] : 0.f;
#pragma unroll
        for (int o = 1; o < 32; o <<= 1) sp += shx(sp, o, lane);
        const float rs = rsqrtf(sp * (1.f / DM) + EPS);
#pragma unroll
        for (int e = 0; e < 16; ++e) v[e] = v[e] * rs * gv[e];
        const int b = m >> 12, t = m & 4095, c = t >> 4, jj = t & 15;
        u32x4* dst = (u32x4*)(A2 + ((size_t)lane * 4096 + b * 256 + c) * S5K + jj * 16);
        dst[0] = pack8(v); dst[1] = pack8(v + 8);
    }
}

__device__ __forceinline__ void p_lat(const Tbl a, int li, bf16_t* PROJ, int gw, int ngw, int lane) {
    asm volatile("" : "+v"(lane)); asm volatile("" : "+s"(gw));
    int seg0, slen, sdim; const float* gp = a.in(4); float extra = 1.f;
    if (lane < 8) { seg0 = 0; slen = 8; sdim = 256; gp = a.in(4) + li * 256 + 32 * lane; }
    else if (lane < 12) { seg0 = 8; slen = 4; sdim = 128; gp = a.in(6) + li * 128 + 32 * (lane - 8); }
    else if (lane == 12) { seg0 = 12; slen = 1; sdim = 32; }
    else if (lane < 29) { seg0 = 13 + ((lane - 13) & ~1); slen = 2; sdim = 64; gp = a.in(10) + li * 64 + 32 * ((lane - 13) & 1); extra = 0.125f * LOG2E; }
    else if (lane < 45) { seg0 = 29 + ((lane - 29) & ~1); slen = 2; sdim = 64; gp = a.in(11) + li * 64 + 32 * ((lane - 29) & 1); }
    else { seg0 = lane; slen = 1; sdim = 32; }
    const f32x2* rope = (const f32x2*)(a.ws() + WS_ROPE);
    u32x4 nx[4];
#pragma unroll
    for (int q = 0; q < 4; ++q) nx[q] = (u32x4){0, 0, 0, 0};
    if (lane < 45 && gw < MTOK) {
#pragma unroll
        for (int q = 0; q < 4; ++q) nx[q] = ((const u32x4*)(PROJ + (size_t)gw * INP + 32 * lane))[q]; }
    for (int m = gw; m < MTOK; m += ngw) {
        u32x4* rp = (u32x4*)(PROJ + (size_t)m * INP + 32 * lane);
        float v[32];
#pragma unroll
        for (int q = 0; q < 4; ++q) unpack8(nx[q], v + 8 * q);
        if (lane < 45 && m + ngw < MTOK) {
#pragma unroll
            for (int q = 0; q < 4; ++q) nx[q] = ((const u32x4*)(PROJ + (size_t)(m + ngw) * INP + 32 * lane))[q]; }
        float ss = 0.f;
#pragma unroll
        for (int e = 0; e < 32; ++e) ss += v[e] * v[e];
        float tot = 0.f;
#pragma unroll
        for (int k = 0; k < 8; ++k) { const float o = bperm((seg0 + k) & 63, ss); if (k < slen) tot += o; }
        if (lane == 12) { const f32x2* rr = rope + (size_t)(m & 4095) * 16;
#pragma unroll
            for (int i = 0; i < 16; ++i) { const f32x2 cs = rr[i]; const float x1 = v[i], x2 = v[16 + i]; v[i] = x1 * cs.x - x2 * cs.y; v[16 + i] = x1 * cs.y + x2 * cs.x; } }
        else if (lane < 45) { const float sc = rsqrtf(tot / (float)sdim + EPS) * extra;
#pragma unroll
            for (int e = 0; e < 32; ++e) v[e] = v[e] * sc * gp[e]; }
        if (lane < 45) {
#pragma unroll
            for (int q = 0; q < 4; ++q) rp[q] = pack8(v + 8 * q); }
    }
}

__device__ __forceinline__ void p_qk(const Tbl a, int li, const bf16_t* PROJ, bf16_t* QR, const bf16_t* KVR, bf16_t* KM, int gw, int ngw, int lane) {
    asm volatile("" : "+v"(lane)); asm volatile("" : "+s"(gw));
    const int h = lane / 6, j = lane - 6 * h; const bool act = lane < 48;
    const int d0 = j < 4 ? 16 * j : 64 + 8 * (j - 4), d1 = j < 4 ? 16 * j + 8 : 80 + 8 * (j - 4);
    const float* gq = a.in(8) + li * 96; const float* gk = a.in(9) + li * 96;
    const f32x2* rope = (const f32x2*)(a.ws() + WS_ROPE);
    const float qscale = 0.10206207261596577f * LOG2E;
    const bf16_t* kb0 = j < 4 ? KVR + 128 * h + d0 : PROJ + C_KR + (d0 - 64); const bf16_t* kb1 = j < 4 ? KVR + 128 * h + d1 : PROJ + C_KR + (d1 - 64);
    const size_t kpitch = j < 4 ? 1024 : INP;
    u32x4 nq0 = (u32x4){0, 0, 0, 0}, nq1 = nq0, nk0 = nq0, nk1 = nq0;
    if (act && gw < MTOK) { nq0 = *(const u32x4*)(QR + (size_t)gw * 768 + 96 * h + d0); nq1 = *(const u32x4*)(QR + (size_t)gw * 768 + 96 * h + d1);
        nk0 = *(const u32x4*)(kb0 + (size_t)gw * kpitch); nk1 = *(const u32x4*)(kb1 + (size_t)gw * kpitch); }
    for (int m = gw; m < MTOK; m += ngw) {
        float q0[8], q1[8], k0[8], k1[8];
        if (act) {
            unpack8(nq0, q0); unpack8(nq1, q1); unpack8(nk0, k0); unpack8(nk1, k1);
            if (m + ngw < MTOK) { const size_t mn = (size_t)(m + ngw);
                nq0 = *(const u32x4*)(QR + mn * 768 + 96 * h + d0); nq1 = *(const u32x4*)(QR + mn * 768 + 96 * h + d1);
                nk0 = *(const u32x4*)(kb0 + mn * kpitch); nk1 = *(const u32x4*)(kb1 + mn * kpitch); }
            if (j >= 4) { const f32x2* rr = rope + (size_t)(m & 4095) * 16 + 8 * (j - 4);
#pragma unroll
                for (int e = 0; e < 8; ++e) { const f32x2 cs = rr[e]; const float x1 = q0[e], x2 = q1[e]; q0[e] = x1 * cs.x - x2 * cs.y; q1[e] = x1 * cs.y + x2 * cs.x; } }
        } else {
#pragma unroll
            for (int e = 0; e < 8; ++e) { q0[e] = q1[e] = k0[e] = k1[e] = 0.f; } }
        float sq = 0.f, sk = 0.f;
#pragma unroll
        for (int e = 0; e < 8; ++e) { sq += q0[e] * q0[e] + q1[e] * q1[e]; sk += k0[e] * k0[e] + k1[e] * k1[e]; }
        float tq = 0.f, tk = 0.f;
#pragma unroll
        for (int k = 0; k < 6; ++k) { const int src = (6 * h + k) & 63; tq += bperm(src, sq); tk += bperm(src, sk); }
        if (act) {
            const float scq = rsqrtf(tq * (1.f / 96.f) + EPS) * qscale, sck = rsqrtf(tk * (1.f / 96.f) + EPS);
#pragma unroll
            for (int e = 0; e < 8; ++e) { q0[e] *= scq * gq[d0 + e]; q1[e] *= scq * gq[d1 + e]; k0[e] *= sck * gk[d0 + e]; k1[e] *= sck * gk[d1 + e]; }
            *(u32x4*)(QR + (size_t)m * 768 + 96 * h + d0) = pack8(q0); *(u32x4*)(QR + (size_t)m * 768 + 96 * h + d1) = pack8(q1);
            *(u32x4*)(KM + (size_t)m * 768 + 96 * h + d0) = pack8(k0); *(u32x4*)(KM + (size_t)m * 768 + 96 * h + d1) = pack8(k1);
        }
    }
}

#define ws (a.ws())
#define out (a.out())
#define XN ((bf16_t*)(ws + WS_XN))
#define OB ((bf16_t*)(ws + WS_OB))
#define ROWSS(i) ((float*)(ws + WS_ROWSS) + (size_t)((i) & 1) * MTOK * 32)
#define RSV(i) ((float*)(ws + WS_RS) + (size_t)((i) & 1) * MTOK)
#define FINALIZE_RS(i, ns) do { const int t_ = tid_of(wave); for (int r_ = obid() * 512 + t_; r_ < MTOK; r_ += G * 512) RSV(i)[r_] = row_rs(ROWSS(i), r_, ns); GSYNC(); } while (0)
#define PROJ ((bf16_t*)(ws + WS_PROJ))
#define QR ((bf16_t*)(ws + WS_QR))
#define KVR ((bf16_t*)(ws + WS_KVR))
#define KM ((bf16_t*)(ws + WS_KM))
#define HID ((bf16_t*)(ws + WS_HID))
#define A2 ((bf16_t*)(ws + WS_A2))
#define XS ((bf16_t*)(ws + WS_XS))
#define GS ((bf16_t*)(ws + WS_GS))
#define KMEAN ((bf16_t*)(ws + WS_KMEAN))

#define GSYNC() do { const XcdBarrier xb_{(unsigned*)ws, xb_xcc_id(), (volatile LAS unsigned*)(lds + ARGTBL_OFF + 256)}; xcd_barrier(xb_, wave); } while (0)
template <int layer>
__device__ __forceinline__ void run_layer(const Tbl a, LAS unsigned char* lds, const int G, const int wave) {
    const int tid = tid_of(wave);
    const int lane = tid & 63;
    const int gw = obid() * 8 + wave, ngw = G * 8;
    pg8::StaticOrder S;
        const int li = layer >> 1;
        if ((layer & 1) == 0) {
            { pg8::Gemm g{XN, (const bf16_t*)(ws + WS_WIN) + (size_t)li * INP * DM, MTOK, INP, DM, DM, DM, -1, 0}; S.init(MTOK, INP, G, obid());
              EpiBf16<0, 2> E{PROJ, INP, RSV(2 * layer), 0}; pg8::gemm_phase(lds, g, S, E, wave); }
            GSYNC();
            p_lat(a, li, PROJ, gw, ngw, lane);
            GSYNC();
            { pg8::Gemm g{PROJ + C_CQ, (const bf16_t*)(ws + WS_WUQ) + (size_t)li * 768 * 256, MTOK, 768, 256, INP, 256, -1, 0}; S.init(MTOK, 768, G, obid());
              EpiBf16<0, 2> E{QR, 768, nullptr, 0}; pg8::gemm_phase(lds, g, S, E, wave); }
            { pg8::Gemm g{PROJ + C_CKV, (const bf16_t*)(ws + WS_WUKV) + (size_t)li * 1024 * 128, MTOK, 1024, 128, INP, 128, -1, 0}; S.init(MTOK, 1024, G, obid());
              EpiBf16<0, 2> E{KVR, 1024, nullptr, 0}; pg8::gemm_phase(lds, g, S, E, wave); }
            GSYNC();
            p_qk(a, li, PROJ, QR, KVR, KM, gw, ngw, lane);
            for (int c = obid(); c < 256; c += G) {
                const int tid = tid_of(wave); const int lane = tid & 63;
                const int b = c >> 4, blk = c & 15; LAS float* red = (LAS float*)lds;
                float s8[8];
#pragma unroll
                for (int e = 0; e < 8; ++e) s8[e] = 0.f;
                for (int r = 0; r < 32; ++r) { float f[8]; unpack8(*(const u32x4*)(PROJ + (size_t)(b * SEQ + blk * 256 + wave * 32 + r) * INP + C_KB + 8 * lane), f);
#pragma unroll
                    for (int e = 0; e < 8; ++e) s8[e] += f[e]; }
#pragma unroll
                for (int e = 0; e < 8; ++e) red[wave * 512 + 8 * lane + e] = s8[e];
                __syncthreads();
                { float s = 0.f;
#pragma unroll
                  for (int w = 0; w < 8; ++w) s += red[w * 512 + tid];
                  KMEAN[((size_t)(b * 8 + (tid >> 6)) * 16 + blk) * 64 + (tid & 63)] = (bf16_t)f2bf(s * (1.f / 256.f)); }
                __syncthreads();
            }
            GSYNC();
            for (int c = obid(); c < 256; c += G) {
                const int xcd = c & 7, j = c >> 3, side = j & 1, h = (j >> 1) & 7, b = 2 * xcd + (j >> 4); const size_t r0 = (size_t)b * SEQ;
                const unsigned m0 = 0x9999u;
                const unsigned qm_mla = side ? (~m0 & 0xffffu) : m0, qm_moba = side ? m0 : (~m0 & 0xffffu);
                attn_head<96, false>(QR + r0 * 768 + 96 * h, 768, KM + r0 * 768 + 96 * h, 768, KVR + r0 * 1024 + 128 * h + 64, 1024, OB + r0 * DM + 64 * h, DM, nullptr, (LAS char*)lds, qm_mla, wave, ((const int*)(ws + WS_FLAGS))[li * 2] != 0);
                attn_head<64, true>(PROJ + r0 * INP + C_QB + 64 * h, INP, PROJ + r0 * INP + C_KB + 64 * h, INP, PROJ + r0 * INP + C_VB + 64 * h, INP, OB + r0 * DM + 512 + 64 * h, DM,
                                    KMEAN + (size_t)(b * 8 + h) * 16 * 64, (LAS char*)lds, qm_moba, wave, ((const int*)(ws + WS_FLAGS))[li * 2 + 1] != 0);
            }
            GSYNC();
            { pg8::Gemm g{OB, (const bf16_t*)(ws + WS_WO) + (size_t)li * DM * DM, MTOK, DM, DM, DM, DM, -1, 0}; S.init(MTOK, DM, G, obid());
              EpiResid E{XN, ROWSS(2 * layer + 1), nullptr}; pg8::gemm_phase(lds, g, S, E, wave); }
            GSYNC();
            FINALIZE_RS(2 * layer + 1, 16);
        } else {
            norm_rows_s5(XN, ROWSS(2 * layer), 16, a.in(1) + layer * DM, A2, gw, ngw, lane);
            GSYNC();
            { pg8::Gemm g{A2, (const bf16_t*)(ws + WS_S5A) + (size_t)li * 64 * 256 * 256, S5ROWS, 256, 256, S5K, 256, 4, 0}; S.init(S5ROWS, 256, G, obid());
              EpiBf16<0, 1> E{XS, 128, nullptr, 0}; pg8::gemm_phase(lds, g, S, E, wave); }
            GSYNC();
            const int tid_s = tid_of(wave);
            for (int idx = obid() * 512 + tid_s; idx < 65536; idx += G * 512) {
                const int p = idx & 63, b = (idx >> 6) & 15, grp = idx >> 10;
                const float* A16 = (const float*)(ws + WS_A16) + (size_t)((li * 64 + grp) * 64 + p) * 2; const float ar = A16[0], ai = A16[1];
                const size_t r0 = (size_t)grp * 4096 + b * 256; float hr = 0.f, hi_ = 0.f;
                const unsigned* XS32 = (const unsigned*)XS; unsigned* A232 = (unsigned*)A2;
                for (int c0 = 0; c0 < 256; c0 += 32) { unsigned xw[32];
#pragma unroll
                    for (int k = 0; k < 32; ++k) xw[k] = XS32[(r0 + c0 + k) * 64 + p];
#pragma unroll
                    for (int k = 0; k < 32; ++k) { A232[(r0 + c0 + k) * (S5K / 2) + 128 + p] = pk2(hr, hi_);
                        const float nr = ar * hr - ai * hi_ + bf_lo(xw[k]), ni = ar * hi_ + ai * hr + bf_hi(xw[k]); hr = nr; hi_ = ni; } }
            }
            GSYNC();
            { pg8::Gemm g{A2, (const bf16_t*)(ws + WS_S5B) + (size_t)li * 64 * 256 * S5K, S5ROWS, 256, S5K, S5K, S5K, 4, 0}; S.init(S5ROWS, 256, G, obid());
              EpiS5Y E{GS}; pg8::gemm_phase(lds, g, S, E, wave); }
            GSYNC();
            { pg8::Gemm g{GS, (const bf16_t*)(ws + WS_WGLU) + (size_t)li * 2048 * DM, MTOK, 2048, DM, 16, DM, -1, 1}; S.init(MTOK, 2048, G, obid());
              EpiGlu E{XN, ROWSS(2 * layer + 1)}; pg8::gemm_phase(lds, g, S, E, wave); }
            GSYNC();
            FINALIZE_RS(2 * layer + 1, 32);
        }
        { pg8::Gemm g{XN, (const bf16_t*)(ws + WS_W1) + (size_t)layer * DFF * DM, MTOK, DFF, DM, DM, DM, -1, 0}; S.init(MTOK, DFF, G, obid());
          EpiBf16<1, 2> E{HID, DFF, RSV(2 * layer + 1), 0}; pg8::gemm_phase(lds, g, S, E, wave); }
        GSYNC();
        { pg8::Gemm g{HID, (const bf16_t*)(ws + WS_W2) + (size_t)layer * DM * DFF, MTOK, DM, DFF, DFF, DFF, -1, 0}; S.init(MTOK, DM, G, obid());
          EpiResid E{XN, ROWSS(2 * layer + 2), (layer < DEPTH - 1) ? (float*)nullptr : out}; pg8::gemm_phase(lds, g, S, E, wave); }
        GSYNC();
        if (layer == 1) FINALIZE_RS(2 * layer + 2, 16);
    }

__global__ void __launch_bounds__(512, 2) fwd_mega(Args a_unused) {
    extern __shared__ __attribute__((aligned(16))) unsigned char lds_raw[];
    cg::grid_group grid = cg::this_grid();
    LAS unsigned char* lds = (LAS unsigned char*)lds_raw;
    {
        const unsigned __attribute__((address_space(4)))* kp = (const unsigned __attribute__((address_space(4)))*)__builtin_amdgcn_kernarg_segment_ptr();
        if (threadIdx.x < 52) ((LAS unsigned*)(lds + ARGTBL_OFF))[threadIdx.x] = kp[threadIdx.x];
        if (threadIdx.x >= 64 && threadIdx.x < 66) ((LAS unsigned*)(lds + ARGTBL_OFF + 256))[threadIdx.x - 64] = 0u;
        __syncthreads();
    }
    const Tbl a{(const LAS unsigned*)(lds + ARGTBL_OFF)};
    const int tid = threadIdx.x, lane = tid & 63, wave = __builtin_amdgcn_readfirstlane(tid >> 6);
    const int G = gridDim.x, gw = blockIdx.x * 8 + wave, ngw = G * 8;
    {
        if (blockIdx.x == 0) for (int e = threadIdx.x; e < XCD_BAR_WORDS; e += 512) __hip_atomic_store((unsigned*)ws + e, 0u, __ATOMIC_RELAXED, __HIP_MEMORY_SCOPE_AGENT);
        for (int it = blockIdx.x; it < 256; it += G) s5_prep(a, it >> 7, (it >> 1) & 63, (LAS char*)lds, it & 1);
        LAS float* scr = (LAS float*)(lds + wave * 16384);
        for (int i = 0; i < 2; ++i) {
            tr_matrix(a.in(3) + (size_t)i * DM * INC, DM, INC, (bf16_t*)(ws + WS_WIN) + (size_t)i * INP * DM, DM, 0, scr, gw, ngw, lane, a.in(1) + 2 * i * DM);
            tr_matrix(a.in(5) + (size_t)i * 256 * 768, 256, 768, (bf16_t*)(ws + WS_WUQ) + (size_t)i * 768 * 256, 256, 0, scr, gw, ngw, lane);
            tr_matrix(a.in(7) + (size_t)i * 128 * 1024, 128, 1024, (bf16_t*)(ws + WS_WUKV) + (size_t)i * 1024 * 128, 128, 0, scr, gw, ngw, lane);
            tr_matrix(a.in(12) + (size_t)i * DM * DM, DM, DM, (bf16_t*)(ws + WS_WO) + (size_t)i * DM * DM, DM, 0, scr, gw, ngw, lane);
            tr_matrix(a.in(21) + (size_t)i * DM * 2048, DM, 2048, (bf16_t*)(ws + WS_WGLU) + (size_t)i * 2048 * DM, DM, 1, scr, gw, ngw, lane);
        }
        for (int i = 0; i < DEPTH; ++i) {
            tr_matrix(a.in(22) + (size_t)i * DM * DFF, DM, DFF, (bf16_t*)(ws + WS_W1) + (size_t)i * DFF * DM, DM, 0, scr, gw, ngw, lane, a.in(2) + i * DM);
            tr_matrix(a.in(23) + (size_t)i * DFF * DM, DFF, DM, (bf16_t*)(ws + WS_W2) + (size_t)i * DM * DFF, DFF, 0, scr, gw, ngw, lane);
        }
        const int gt = blockIdx.x * 512 + tid, ngt = G * 512;
        for (int e = gt; e < 2 * (INP - INC) * DM / 8; e += ngt) {
            const int i = e / ((INP - INC) * DM / 8), r = e % ((INP - INC) * DM / 8);
            *(u32x4*)((bf16_t*)(ws + WS_WIN) + (size_t)i * INP * DM + (size_t)INC * DM + (size_t)r * 8) = (u32x4){0, 0, 0, 0}; }
        if (blockIdx.x == 1 % G && tid < 4) {
            const int li_ = tid >> 1, ty = tid & 1, d = ty ? 64 : 96; const float* gq = a.in(ty ? 10 : 8) + li_ * d; const float* gk = a.in(ty ? 11 : 9) + li_ * d;
            float mq = 0.f, mk = 0.f; for (int e = 0; e < d; ++e) { mq = fmaxf(mq, fabsf(gq[e])); mk = fmaxf(mk, fabsf(gk[e])); }
            ((int*)(ws + WS_FLAGS))[tid] = (sqrtf((float)d) * mq * mk * LOG2E < 64.f) ? 1 : 0; }
        cast_rows(a.in(0), XN, RSV(0), gw, ngw, lane);
        for (int e = gt; e < SEQ * 16; e += ngt) { const int pos = e >> 4, i = e & 15;
            const float inv = exp2f(-(float)i * (13.287712379549449f / 16.f)); float rev = ((float)pos * inv) * 0.15915494309189535f; rev -= rintf(rev);
            ((f32x2*)(ws + WS_ROPE))[e] = (f32x2){__builtin_amdgcn_cosf(rev), __builtin_amdgcn_sinf(rev)}; }
    }
    grid.sync();
    (void)xcd_barrier_post((unsigned*)ws, (volatile LAS unsigned*)(lds + ARGTBL_OFF + 256));

    run_layer<0>(a, lds, G, wave); run_layer<1>(a, lds, G, wave); run_layer<2>(a, lds, G, wave); run_layer<3>(a, lds, G, wave);
#undef ws
#undef out
#undef GSYNC
#undef FINALIZE_RS
}

extern "C" void kernel_launch(void* const* d_in, const int* in_sizes, int n_in, void* d_out, int out_size, void* d_ws, size_t ws_size, hipStream_t stream) {
    static int grid = 0;
    if (grid == 0) {
        if (n_in != 24 || out_size != MTOK * DM || ws_size < WS_END) { fprintf(stderr, "kernel_launch: unexpected shapes (n_in %d out %d ws %zu)\n", n_in, out_size, ws_size); grid = -1; return; }
        int dev = 0, cus = 0, per_cu = 0;
        hipGetDevice(&dev); hipDeviceGetAttribute(&cus, hipDeviceAttributeMultiprocessorCount, dev);
        hipFuncSetAttribute((const void*)fwd_mega, hipFuncAttributeMaxDynamicSharedMemorySize, LDS_BYTES);
        hipOccupancyMaxActiveBlocksPerMultiprocessor(&per_cu, (const void*)fwd_mega, 512, LDS_BYTES);
        if (per_cu < 1) { fprintf(stderr, "kernel_launch: occupancy query says %d blocks/CU\n", per_cu); per_cu = 1; }
        (void)hipGetLastError();
        grid = cus * 1;
    }
    if (grid < 0) return;
    Args a{};
    for (int i = 0; i < 24; ++i) a.in[i] = (const float*)d_in[i];
    a.out = (float*)d_out; a.ws = (unsigned char*)d_ws;
    void* args[] = {&a};
    hipError_t e = hipLaunchCooperativeKernel((const void*)fwd_mega, dim3(grid), dim3(512), args, LDS_BYTES, stream);
    if (e != hipSuccess) fprintf(stderr, "cooperative launch failed: %s (grid %d)\n", hipGetErrorString(e), grid);
}
```
